# Optimizing an MI355X kernel written in HIP

```python
import math
import jax, jax.numpy as jnp
from jax import lax
import numpy as np

D_MODEL = 1024
BATCH = 2
SEQ = 8192
DEPTH = 1

MIX_WIDTH = D_MODEL
DIFF_HEADS = 4
DIFF_HEAD_DIM = 64
DIFF_V_DIM = 2 * DIFF_HEAD_DIM
DIFF_WIDTH = DIFF_HEADS * DIFF_V_DIM
Q_BLOCK = 128
GLA_HEADS = 4
GLA_V_DIM = 128
GLA_K_DIM = GLA_V_DIM // 2
GLA_WIDTH = GLA_HEADS * GLA_V_DIM
GLA_GATE_RANK = 16
GLA_GATE_TEMP = 16.0
GLA_CHUNK = 64
IN_SPLITS = (
    DIFF_HEADS * 2 * DIFF_HEAD_DIM,
    DIFF_HEADS * 2 * DIFF_HEAD_DIM,
    DIFF_HEADS * DIFF_V_DIM,
    GLA_HEADS * GLA_K_DIM,
    GLA_HEADS * GLA_K_DIM,
    GLA_HEADS * GLA_V_DIM,
    GLA_HEADS * GLA_V_DIM,
    GLA_GATE_RANK,
)
IN_WIDTH = sum(IN_SPLITS)
D_FF = int(math.ceil(8 * D_MODEL / 3 / 256) * 256)
EPS = 1e-6

kernel_name = "hybrid_diffattn_gla_parallel_heads"


def rms_norm(x, g):
    xf = x.astype(jnp.float32)
    y = xf * lax.rsqrt(jnp.mean(xf * xf, axis=-1, keepdims=True) + EPS)
    return (y * g.astype(jnp.float32)).astype(x.dtype)


def diff_attention(q, k, v, lam):
    B, H, _, T, d = q.shape
    nb = T // Q_BLOCK
    scale = DIFF_HEAD_DIM ** -0.5
    slopes = 2.0 ** (-8.0 * (jnp.arange(H, dtype=jnp.float32) + 1.0) / H)
    qb = jnp.moveaxis(q.reshape(B, H, 2, nb, Q_BLOCK, d), 3, 0)
    kpos = jnp.arange(T, dtype=jnp.float32)

    def block(args):
        qblk, i = args
        qpos = (i * Q_BLOCK + jnp.arange(Q_BLOCK)).astype(jnp.float32)
        dist = qpos[:, None] - kpos[None, :]
        bias = jnp.where(dist[None] >= 0, -slopes[:, None, None] * dist[None], -jnp.inf)
        s = jnp.einsum('bhjqd,bhjkd->bhjqk', qblk, k).astype(jnp.float32) * scale
        p = jax.nn.softmax(s + bias[None, :, None], axis=-1)
        w = (p[:, :, 0] - lam * p[:, :, 1]).astype(v.dtype)
        return jnp.einsum('bhqk,bhkv->bhqv', w, v)

    out = lax.map(block, (qb, jnp.arange(nb)))
    return out.transpose(1, 0, 3, 2, 4).reshape(B, T, H, v.shape[-1])


def gla_chunked(q, k, v, g):
    B, T, H, dk = q.shape
    dv = v.shape[-1]
    n = T // GLA_CHUNK
    out_dtype = v.dtype

    def to_chunks(a):
        return a.astype(jnp.float32).reshape(B, n, GLA_CHUNK, H, a.shape[-1]).transpose(1, 0, 3, 2, 4)

    qc, kc, vc, gc = map(to_chunks, (q, k, v, g))
    causal = jnp.tril(jnp.ones((GLA_CHUNK, GLA_CHUNK), dtype=bool))

    def step(S, inp):
        qi, ki, vi, gi = inp
        b = jnp.cumsum(gi, axis=-2)
        o_inter = jnp.einsum('bhck,bhkv->bhcv', qi * jnp.exp(b), S)
        diff = b[:, :, :, None, :] - b[:, :, None, :, :]
        decay = jnp.exp(jnp.where(causal[None, None, :, :, None], diff, -jnp.inf))
        A = jnp.einsum('bhtk,bhsk,bhtsk->bhts', qi, ki, decay)
        o_intra = jnp.einsum('bhts,bhsv->bhtv', A, vi)
        b_last = b[:, :, -1:, :]
        S_new = jnp.exp(b_last[:, :, 0, :, None]) * S + jnp.einsum(
            'bhck,bhcv->bhkv', ki * jnp.exp(b_last - b), vi)
        return S_new, o_inter + o_intra

    S0 = jnp.zeros((B, H, dk, dv), jnp.float32)
    _, o = lax.scan(step, S0, (qc, kc, vc, gc))
    return o.transpose(1, 0, 3, 2, 4).reshape(B, T, H, dv).astype(out_dtype)


def setup_inputs(seed: int = 0) -> dict:
    key = jax.random.key(seed)
    ks = jax.random.split(key, 20)
    f32 = jnp.float32
    nrm = lambda k, shape, s: jax.random.normal(k, shape, f32) * s
    L = DEPTH
    return {
        "x": jax.random.normal(ks[0], (BATCH, SEQ, D_MODEL), f32),
        "attn_norm_gain": 1.0 + nrm(ks[1], (L, D_MODEL), 0.02),
        "w_in": nrm(ks[2], (L, D_MODEL, IN_WIDTH), D_MODEL ** -0.5),
        "q_norm_gain": 1.0 + nrm(ks[3], (L, DIFF_HEAD_DIM), 0.02),
        "k_norm_gain": 1.0 + nrm(ks[4], (L, DIFF_HEAD_DIM), 0.02),
        "lambda_q1": nrm(ks[5], (L, DIFF_HEAD_DIM), 0.1),
        "lambda_k1": nrm(ks[6], (L, DIFF_HEAD_DIM), 0.1),
        "lambda_q2": nrm(ks[7], (L, DIFF_HEAD_DIM), 0.1),
        "lambda_k2": nrm(ks[8], (L, DIFF_HEAD_DIM), 0.1),
        "diff_out_norm_gain": 1.0 + nrm(ks[9], (L, DIFF_V_DIM), 0.02),
        "w_gla_gate_up": nrm(ks[10], (L, GLA_GATE_RANK, GLA_HEADS * GLA_K_DIM), GLA_GATE_RANK ** -0.5),
        "b_gla_gate": nrm(ks[11], (L, GLA_HEADS * GLA_K_DIM), 0.01),
        "gla_out_norm_gain": 1.0 + nrm(ks[12], (L, GLA_V_DIM), 0.02),
        "w_out": nrm(ks[13], (L, MIX_WIDTH, D_MODEL), MIX_WIDTH ** -0.5),
        "ffn_norm_gain": 1.0 + nrm(ks[14], (L, D_MODEL), 0.02),
        "w_ffn_gate": nrm(ks[15], (L, D_MODEL, D_FF), D_MODEL ** -0.5),
        "w_ffn_up": nrm(ks[16], (L, D_MODEL, D_FF), D_MODEL ** -0.5),
        "w_ffn_down": nrm(ks[17], (L, D_FF, D_MODEL), D_FF ** -0.5),
    }


def reference(x, attn_norm_gain, w_in, q_norm_gain, k_norm_gain, lambda_q1, lambda_k1,
              lambda_q2, lambda_k2, diff_out_norm_gain, w_gla_gate_up, b_gla_gate,
              gla_out_norm_gain, w_out, ffn_norm_gain, w_ffn_gate, w_ffn_up, w_ffn_down):
    B, T, _ = x.shape
    split_pts = np.cumsum(IN_SPLITS)[:-1].tolist()
    h = x
    for l in range(DEPTH):
        lambda_init = 0.8 - 0.6 * math.exp(-0.3 * l)
        n = rms_norm(h, attn_norm_gain[l])
        proj = n @ w_in[l]
        dq, dk_, dv, gq, gk, gv, gout, glr = jnp.split(proj, split_pts, axis=-1)

        dq = rms_norm(dq.reshape(B, T, DIFF_HEADS, 2, DIFF_HEAD_DIM), q_norm_gain[l])
        dk_ = rms_norm(dk_.reshape(B, T, DIFF_HEADS, 2, DIFF_HEAD_DIM), k_norm_gain[l])
        dq = dq.transpose(0, 2, 3, 1, 4)
        dk_ = dk_.transpose(0, 2, 3, 1, 4)
        dv = dv.reshape(B, T, DIFF_HEADS, DIFF_V_DIM).transpose(0, 2, 1, 3)
        lam = (jnp.exp(jnp.sum(lambda_q1[l].astype(jnp.float32) * lambda_k1[l].astype(jnp.float32)))
               - jnp.exp(jnp.sum(lambda_q2[l].astype(jnp.float32) * lambda_k2[l].astype(jnp.float32)))
               + lambda_init)
        o_diff = diff_attention(dq, dk_, dv, lam)
        o_diff = rms_norm(o_diff, diff_out_norm_gain[l]) * (1.0 - lambda_init)

        gq = gq.reshape(B, T, GLA_HEADS, GLA_K_DIM) * (GLA_K_DIM ** -0.5)
        gk = gk.reshape(B, T, GLA_HEADS, GLA_K_DIM)
        gv = gv.reshape(B, T, GLA_HEADS, GLA_V_DIM)
        log_alpha = jax.nn.log_sigmoid(
            (glr @ w_gla_gate_up[l] + b_gla_gate[l]).astype(jnp.float32)) / GLA_GATE_TEMP
        log_alpha = log_alpha.reshape(B, T, GLA_HEADS, GLA_K_DIM)
        o_gla = gla_chunked(gq, gk, gv, log_alpha)
        o_gla = rms_norm(o_gla, gla_out_norm_gain[l]) * jax.nn.silu(
            gout.reshape(B, T, GLA_HEADS, GLA_V_DIM))

        mixed = jnp.concatenate([o_diff.reshape(B, T, DIFF_WIDTH),
                                 o_gla.reshape(B, T, GLA_WIDTH)], axis=-1)
        h = h + mixed @ w_out[l]

        m = rms_norm(h, ffn_norm_gain[l])
        h = h + (jax.nn.silu(m @ w_ffn_gate[l]) * (m @ w_ffn_up[l])) @ w_ffn_down[l]
    return h
```

```cpp
#include <hip/hip_runtime.h>
#include <hip/hip_cooperative_groups.h>
#include <cstdio>
#include <cstdint>
namespace cg = cooperative_groups;
#define MK_N_LAUNCHES 1
#define REPEAT_MASK 0

namespace pg8 {
#define PG8_LAS __attribute__((address_space(3)))
typedef unsigned short bf16_t;
typedef short bf16x8 __attribute__((ext_vector_type(8)));
typedef float f32x4 __attribute__((ext_vector_type(4)));
typedef unsigned u32x4 __attribute__((ext_vector_type(4)));
constexpr int BM = 256, BK = 64, HALF = 128, HTB = HALF * BK * 2  , STAGE_BYTES = 8 * HTB, NXCD = 8, WGM = 8;

__host__ __device__ __forceinline__ int lds_byte(int r, int c) { const int st = (r >> 4) * 2 + (c >> 5), rr = r & 15, cc = c & 31, ob = rr * 64 + cc * 2; return st * 1024 + (ob ^ (((ob >> 9) & 1) << 5)); }
__host__ __device__ __forceinline__ void stage_rc(int b, int& R, int& C) { const int st = b / 1024, sb = b % 1024, swz = sb ^ (((sb >> 9) & 1) << 5); R = (st >> 1) * 16 + swz / 64; C = (st & 1) * 32 + (swz % 64) / 2; }
__host__ __device__ __forceinline__ int perm32(int rho) { const int n = rho >> 4, i = rho & 15; return 8 * (i >> 2) + 4 * n + (i & 3); }

struct Unit { int pm, pn; };
struct Gemm { const bf16_t* A; const bf16_t* Bt; int M, N, K; };

struct StaticOrder {
    int nM, nN, nwg, G, c;
    __host__ __device__ void init(int M, int N, int G_, int c_) { nM = M / BM; nN = N / BM; nwg = nM * nN; G = G_; c = c_; }
    __host__ __device__ bool next(int i, Unit& u) const {
        const long L = (long)i * G + c; if (L >= nwg) return false;
        int wgid = (int)L; { const int q = nwg / NXCD, r = nwg % NXCD, xcd = wgid % NXCD, off = wgid / NXCD; wgid = (xcd < r ? xcd * (q + 1) : r * (q + 1) + (xcd - r) * q) + off; }
        const int nig = WGM * nN, gid = wgid / nig, fm = gid * WGM, gsz = (nM - fm) < WGM ? (nM - fm) : WGM;
        u.pm = fm + ((wgid % nig) % gsz); u.pn = (wgid % nig) / gsz; return true;
    }
    __device__ __forceinline__ void a_ready(const Unit&) const {}
    __device__ __forceinline__ void done(const Unit&) const {}
};

__device__ __forceinline__ unsigned cvt_pk_bf16(float lo, float hi) { unsigned r; asm volatile("v_cvt_pk_bf16_f32 %0, %1, %2" : "=v"(r) : "v"(lo), "v"(hi)); return r; }
typedef float f32x2 __attribute__((ext_vector_type(2)));
typedef unsigned u32x2 __attribute__((ext_vector_type(2)));
typedef float f32x2_t __attribute__((ext_vector_type(2))); typedef __bf16 bf16x2_t __attribute__((ext_vector_type(2)));
__device__ __forceinline__ unsigned cvtpk(float lo, float hi) { f32x2_t v = {lo, hi}; bf16x2_t b = __builtin_convertvector(v, bf16x2_t); return __builtin_bit_cast(unsigned, b); }
constexpr float RMS_EPS = 1e-6f;
constexpr float LOG2E = 1.4426950408889634f;
constexpr int PROJ_LD = 3072;

struct EpiInProj {
    static constexpr bool PERM = true, AFTER_DRAIN = false;
    bf16_t* proj; bf16_t* vt; bf16_t* gvt; const float* qg; const float* kg;
    __device__ __forceinline__ void operator()(const f32x4 (&acc)[2][2][4][2], const Unit& u, int wr, int wc, int fr, int fq) const {
        const int pn = u.pn; const int row0 = u.pm * BM + wr * 64 + fr;
        if (pn < 4) {
            const float* g = pn < 2 ? qg : kg; const float sc = pn < 2 ? 0.125f * LOG2E : 1.0f;
            f32x4 gv[2][2];
#pragma unroll
            for (int bj = 0; bj < 2; ++bj)
#pragma unroll
                for (int n = 0; n < 2; ++n) gv[bj][n] = *(const f32x4*)(g + 32 * bj + 8 * fq + 4 * n) * sc;
#pragma unroll
            for (int ai = 0; ai < 2; ++ai)
#pragma unroll
                for (int m = 0; m < 4; ++m) {
                    float ss = 0.f;
#pragma unroll
                    for (int bj = 0; bj < 2; ++bj)
#pragma unroll
                        for (int n = 0; n < 2; ++n) { const f32x4 x = acc[ai][bj][m][n]; ss += (x[0] * x[0] + x[1] * x[1]) + (x[2] * x[2] + x[3] * x[3]); }
                    ss += __shfl_xor(ss, 16); ss += __shfl_xor(ss, 32);
                    const float rstd = rsqrtf(ss * (1.0f / 64.0f) + RMS_EPS);
                    bf16_t* rowp = proj + (size_t)(row0 + ai * HALF + m * 16) * PROJ_LD + pn * 256 + wc * 64 + 8 * fq;
#pragma unroll
                    for (int bj = 0; bj < 2; ++bj) { const f32x4 v0 = acc[ai][bj][m][0] * rstd * gv[bj][0], v1 = acc[ai][bj][m][1] * rstd * gv[bj][1];
                        u32x4 w; w.x = cvtpk(v0[0], v0[1]); w.y = cvtpk(v0[2], v0[3]); w.z = cvtpk(v1[0], v1[1]); w.w = cvtpk(v1[2], v1[3]);
                        *(u32x4*)(rowp + 32 * bj) = w; }
                }
        } else if (pn == 4 || pn == 5 || pn == 8 || pn == 9) {
            bf16_t* dst = pn < 6 ? vt : gvt; const int cb = (pn & 1) * 256 + wc * 64 + 8 * fq;
#pragma unroll
            for (int ai = 0; ai < 2; ++ai)
#pragma unroll
                for (int m = 0; m < 4; ++m) { const int row = row0 + ai * HALF + m * 16; const int b = row >> 13, t = row & 8191;
#pragma unroll
                    for (int bj = 0; bj < 2; ++bj)
#pragma unroll
                        for (int n = 0; n < 2; ++n) { const f32x4 x = acc[ai][bj][m][n]; const int c = cb + 32 * bj + 4 * n; const int h = c >> 7, ev = c & 127;
                            bf16_t* p = dst + ((size_t)((b * 4 + h) * 128 + ev)) * 8192 + t; const unsigned w0 = cvtpk(x[0], x[1]), w1 = cvtpk(x[2], x[3]);
                            p[0] = (bf16_t)(w0 & 0xffffu); p[8192] = (bf16_t)(w0 >> 16); p[2 * 8192] = (bf16_t)(w1 & 0xffffu); p[3 * 8192] = (bf16_t)(w1 >> 16); }
                }
        } else {
            const float sc = pn == 6 ? 0.125f : 1.0f;
#pragma unroll
            for (int ai = 0; ai < 2; ++ai)
#pragma unroll
                for (int m = 0; m < 4; ++m) { bf16_t* rowp = proj + (size_t)(row0 + ai * HALF + m * 16) * PROJ_LD + pn * 256 + wc * 64 + 8 * fq;
#pragma unroll
                    for (int bj = 0; bj < 2; ++bj) { const f32x4 v0 = acc[ai][bj][m][0] * sc, v1 = acc[ai][bj][m][1] * sc;
                        u32x4 w; w.x = cvtpk(v0[0], v0[1]); w.y = cvtpk(v0[2], v0[3]); w.z = cvtpk(v1[0], v1[1]); w.w = cvtpk(v1[2], v1[3]);
                        *(u32x4*)(rowp + 32 * bj) = w; }
                }
        }
    }
};
struct EpiOut {
    static constexpr bool PERM = false, AFTER_DRAIN = false;
    const float* x; float* hout; bf16_t* hb; float* rowss;
    __device__ __forceinline__ void operator()(const f32x4 (&acc)[2][2][4][2], const Unit& u, int wr, int wc, int fr, int fq) const {
        const int row0 = u.pm * BM + wr * 64 + fr, col0 = u.pn * BM + wc * 32 + 4 * fq;
#pragma unroll
        for (int ai = 0; ai < 2; ++ai) {
            f32x4 pre[4][2][2];
#pragma unroll
            for (int m = 0; m < 4; ++m) { const size_t off = (size_t)(row0 + ai * HALF + m * 16) * 1024 + col0;
#pragma unroll
                for (int bj = 0; bj < 2; ++bj)
#pragma unroll
                    for (int n = 0; n < 2; ++n) pre[m][bj][n] = *(const f32x4*)(x + off + bj * HALF + n * 16); }
            asm volatile("" ::: "memory");
#pragma unroll
            for (int m = 0; m < 4; ++m) { const int row = row0 + ai * HALF + m * 16; const size_t off = (size_t)row * 1024 + col0; float ss = 0.f;
#pragma unroll
                for (int bj = 0; bj < 2; ++bj)
#pragma unroll
                    for (int n = 0; n < 2; ++n) { const size_t o2 = off + bj * HALF + n * 16; const f32x4 hv = pre[m][bj][n] + acc[ai][bj][m][n];
                        ss += (hv[0] * hv[0] + hv[1] * hv[1]) + (hv[2] * hv[2] + hv[3] * hv[3]);
                        u32x2 w; w.x = cvtpk(hv[0], hv[1]); w.y = cvtpk(hv[2], hv[3]); *(u32x2*)(hb + o2) = w; }
                ss += __shfl_xor(ss, 16); ss += __shfl_xor(ss, 32);
                if (fq == 0) atomicAdd(rowss + row, ss);
            }
            asm volatile("" ::: "memory");
        }
    }
};
struct EpiSwiGLU {
    static constexpr bool PERM = true, AFTER_DRAIN = false;
    bf16_t* hid; const float* rowss;
    __device__ __forceinline__ void operator()(const f32x4 (&acc)[2][2][4][2], const Unit& u, int wr, int wc, int fr, int fq) const {
        const int row0 = u.pm * BM + wr * 64 + fr, col0 = u.pn * 128 + wc * 32 + 8 * fq;
        float rs[2][4];
#pragma unroll
        for (int ai = 0; ai < 2; ++ai)
#pragma unroll
            for (int m = 0; m < 4; ++m) rs[ai][m] = rowss[row0 + ai * HALF + m * 16];
        asm volatile("" ::: "memory");
#pragma unroll
        for (int ai = 0; ai < 2; ++ai)
#pragma unroll
            for (int m = 0; m < 4; ++m) { const int row = row0 + ai * HALF + m * 16; const float r = rsqrtf(rs[ai][m] * (1.0f / 1024.0f) + RMS_EPS);
                float hv[8];
#pragma unroll
                for (int n = 0; n < 2; ++n)
#pragma unroll
                    for (int e = 0; e < 4; ++e) { const float g = acc[ai][0][m][n][e] * r, uu = acc[ai][1][m][n][e] * r;
                        hv[4 * n + e] = g * __builtin_amdgcn_rcpf(1.0f + __builtin_amdgcn_exp2f(-g * LOG2E)) * uu; }
                u32x4 w; w.x = cvtpk(hv[0], hv[1]); w.y = cvtpk(hv[2], hv[3]); w.z = cvtpk(hv[4], hv[5]); w.w = cvtpk(hv[6], hv[7]);
                *(u32x4*)(hid + (size_t)row * 2816 + col0) = w; }
    }
};
struct EpiDown {
    static constexpr bool PERM = false, AFTER_DRAIN = false;
    float* out; const bf16_t* hb;
    __device__ __forceinline__ void operator()(const f32x4 (&acc)[2][2][4][2], const Unit& u, int wr, int wc, int fr, int fq) const {
        const int row0 = u.pm * BM + wr * 64 + fr, col0 = u.pn * BM + wc * 32 + 4 * fq;
#pragma unroll
        for (int ai = 0; ai < 2; ++ai) {
            u32x2 pre[4][2][2];
#pragma unroll
            for (int m = 0; m < 4; ++m) { const size_t off = (size_t)(row0 + ai * HALF + m * 16) * 1024 + col0;
#pragma unroll
                for (int bj = 0; bj < 2; ++bj)
#pragma unroll
                    for (int n = 0; n < 2; ++n) pre[m][bj][n] = *(const u32x2*)(hb + off + bj * HALF + n * 16); }
            asm volatile("" ::: "memory");
#pragma unroll
            for (int m = 0; m < 4; ++m) { const size_t off = (size_t)(row0 + ai * HALF + m * 16) * 1024 + col0;
#pragma unroll
                for (int bj = 0; bj < 2; ++bj)
#pragma unroll
                    for (int n = 0; n < 2; ++n) { const u32x2 hw = pre[m][bj][n];
                        const f32x4 hv = {__uint_as_float(hw.x << 16), __uint_as_float(hw.x & 0xffff0000u), __uint_as_float(hw.y << 16), __uint_as_float(hw.y & 0xffff0000u)};
                        *(f32x4*)(out + off + bj * HALF + n * 16) = hv + acc[ai][bj][m][n]; } }
            asm volatile("" ::: "memory");
        }
    }
};
template <class Epi, class Sched, bool ALIGN_EPI = false, bool SP2 = false>
__device__ __forceinline__ void gemm_phase(PG8_LAS unsigned char* lds, const Gemm g, const Sched& S, const Epi& E) {
    int tid_ = threadIdx.x; asm volatile("" : "+v"(tid_)); const int tid = tid_, wid = __builtin_amdgcn_readfirstlane(tid >> 6), lane = tid & 63, wr = wid >> 2, wc = wid & 3, fr = lane & 15, fq = lane >> 4;
    const int K = g.K, nt = K / BK;
    unsigned voffA[2], voffB[2];
#pragma unroll
    for (int i = 0; i < 2; ++i) { int R, C; stage_rc(tid * 16 + i * 8192, R, C); const int Rb = Epi::PERM ? ((R & ~31) + perm32(R & 31)) : R;
        voffA[i] = (unsigned)(R * K + C) * 2u; voffB[i] = (unsigned)(Rb * K + C) * 2u; }
    const size_t kstep = (size_t)(BK * 2);
    const size_t hstep = (size_t)HALF * K * 2;
    const size_t tstep = 2 * hstep;
    const unsigned ldsw = (unsigned)wid * 1024u;
    const int aoff = lds_byte(wr * 64 + fr, fq * 8), boff = lds_byte(wc * 32 + fr, fq * 8);
#define PG8_SA(b, h) (((b) * 2 + (h)) * HTB)
#define PG8_SB(b, h) ((4 + (b) * 2 + (h)) * HTB)
#define PG8_STAGE(bufoff, gbase, voff) do { _Pragma("unroll") for (int _i = 0; _i < 2; ++_i) \
        __builtin_amdgcn_global_load_lds((const unsigned*)((const char*)(gbase) + (voff)[_i]), (PG8_LAS unsigned*)(lds + (bufoff) + ldsw + _i * 8192), 16, 0, 0); } while (0)
#define PG8_LDA(dst, b, h) do { _Pragma("unroll") for (int m = 0; m < 4; ++m) _Pragma("unroll") for (int k = 0; k < 2; ++k) dst[m][k] = *(const PG8_LAS bf16x8*)(lds + PG8_SA(b, h) + aoff + m * 2048 + k * 1024); } while (0)
#define PG8_LDB(dst, b, h) do { _Pragma("unroll") for (int n = 0; n < 2; ++n) _Pragma("unroll") for (int k = 0; k < 2; ++k) dst[n][k] = *(const PG8_LAS bf16x8*)(lds + PG8_SB(b, h) + boff + n * 2048 + k * 1024); } while (0)
#define PG8_MMA(ai, bj, At, Bt) do { __builtin_amdgcn_s_setprio(1); _Pragma("unroll") for (int m = 0; m < 4; ++m) _Pragma("unroll") for (int n = 0; n < 2; ++n) _Pragma("unroll") for (int k = 0; k < 2; ++k) \
        acc[ai][bj][m][n] = __builtin_amdgcn_mfma_f32_16x16x32_bf16(Bt[n][k], At[m][k], acc[ai][bj][m][n], 0, 0, 0); __builtin_amdgcn_s_setprio(0); } while (0)
#define PG8_WAIT_V(n) asm volatile("s_waitcnt vmcnt(" #n ")" ::: "memory")
#define PG8_WAIT_L(n) asm volatile("s_waitcnt lgkmcnt(" #n ")" ::: "memory")
#define PG8_BAR __builtin_amdgcn_s_barrier()
#define PG8_SCHED __builtin_amdgcn_sched_barrier(0)
    Unit cur, nxt; int ui = 0;
    if (!S.next(0, cur)) return;
    f32x4 acc[2][2][4][2];
#pragma unroll
    for (int a = 0; a < 2; ++a)
#pragma unroll
        for (int b = 0; b < 2; ++b)
#pragma unroll
            for (int m = 0; m < 4; ++m)
#pragma unroll
                for (int n = 0; n < 2; ++n) acc[a][b][m][n] = (f32x4){0.f, 0.f, 0.f, 0.f};
    bf16x8 At[4][2], B0[2][2], B1[2][2];
    const char* cA = (const char*)g.A + (size_t)cur.pm * tstep; const char* cB = (const char*)g.Bt + (size_t)cur.pn * tstep;
    S.a_ready(cur);
    if constexpr (SP2) {
        PG8_STAGE(PG8_SB(0, 0), cB, voffB); PG8_STAGE(PG8_SB(0, 1), cB + hstep, voffB); PG8_STAGE(PG8_SA(0, 0), cA, voffA); PG8_STAGE(PG8_SA(0, 1), cA + hstep, voffA);
        if (wr == 1) PG8_BAR;
        PG8_WAIT_V(2); PG8_BAR;
        PG8_STAGE(PG8_SB(1, 0), cB + kstep, voffB); PG8_STAGE(PG8_SA(1, 0), cA + kstep, voffA); PG8_STAGE(PG8_SB(1, 1), cB + hstep + kstep, voffB);
        PG8_WAIT_V(6); PG8_BAR;
    } else {
        PG8_STAGE(PG8_SB(0, 0), cB, voffB); PG8_STAGE(PG8_SA(0, 0), cA, voffA); PG8_STAGE(PG8_SB(0, 1), cB + hstep, voffB); PG8_STAGE(PG8_SA(0, 1), cA + hstep, voffA);
        if (wr == 1) PG8_BAR;
        PG8_WAIT_V(4); PG8_BAR;
        PG8_STAGE(PG8_SB(1, 0), cB + kstep, voffB); PG8_STAGE(PG8_SA(1, 0), cA + kstep, voffA); PG8_STAGE(PG8_SB(1, 1), cB + hstep + kstep, voffB);
        PG8_WAIT_V(6); PG8_BAR;
    }
    for (;;) {
        const bool has_next = S.next(ui + 1, nxt);
        const char* nA = has_next ? (const char*)g.A + (size_t)nxt.pm * tstep : cA; const char* nB = has_next ? (const char*)g.Bt + (size_t)nxt.pn * tstep : cB;
        for (int t = 0; t < nt; t += 2) {
            const bool last = (t == nt - 2);
            const char* a1 = cA + (size_t)(t + 1) * kstep;
            const char* a2 = last ? nA : cA + (size_t)(t + 2) * kstep; const char* b2 = last ? nB : cB + (size_t)(t + 2) * kstep;
            const char* a3 = a2 + kstep; const char* b3 = b2 + kstep;
            if (last && has_next) S.a_ready(nxt);
            if constexpr (SP2) {
            PG8_LDB(B0, 0, 0); PG8_LDB(B1, 0, 1); PG8_SCHED; PG8_LDA(At, 0, 0); PG8_STAGE(PG8_SA(1, 1), a1 + hstep, voffA);
            PG8_WAIT_V(8); PG8_WAIT_L(0); PG8_BAR; PG8_MMA(0, 0, At, B0); PG8_MMA(0, 1, At, B1); PG8_BAR; PG8_SCHED;
            PG8_LDA(At, 0, 1); PG8_STAGE(PG8_SB(0, 0), b2, voffB); PG8_STAGE(PG8_SB(0, 1), b2 + hstep, voffB); PG8_STAGE(PG8_SA(0, 0), a2, voffA);
            PG8_WAIT_V(8); PG8_WAIT_L(0); PG8_BAR; PG8_MMA(1, 0, At, B0); PG8_MMA(1, 1, At, B1); PG8_BAR; PG8_SCHED;
            PG8_LDB(B0, 1, 0); PG8_LDB(B1, 1, 1); PG8_SCHED; PG8_LDA(At, 1, 0); PG8_STAGE(PG8_SA(0, 1), a2 + hstep, voffA);
            PG8_WAIT_V(8); PG8_WAIT_L(0); PG8_BAR; PG8_MMA(0, 0, At, B0); PG8_MMA(0, 1, At, B1); PG8_BAR; PG8_SCHED;
            PG8_LDA(At, 1, 1); PG8_STAGE(PG8_SB(1, 0), b3, voffB); PG8_STAGE(PG8_SB(1, 1), b3 + hstep, voffB); PG8_STAGE(PG8_SA(1, 0), a3, voffA);
            PG8_WAIT_V(8); PG8_WAIT_L(0); PG8_BAR; PG8_MMA(1, 0, At, B0); PG8_MMA(1, 1, At, B1); PG8_BAR; PG8_SCHED;
            } else {
            PG8_LDB(B0, 0, 0); PG8_SCHED; PG8_LDA(At, 0, 0); PG8_STAGE(PG8_SA(1, 1), a1 + hstep, voffA);
            PG8_WAIT_L(8); PG8_BAR; PG8_WAIT_L(0); PG8_MMA(0, 0, At, B0); PG8_BAR; PG8_SCHED;
            PG8_LDB(B1, 0, 1); PG8_STAGE(PG8_SB(0, 0), b2, voffB);
            PG8_BAR; PG8_WAIT_L(0); PG8_MMA(0, 1, At, B1); PG8_BAR;
            PG8_LDA(At, 0, 1); PG8_STAGE(PG8_SA(0, 0), a2, voffA);
            PG8_BAR; PG8_WAIT_L(0); PG8_MMA(1, 0, At, B0); PG8_BAR; PG8_SCHED;
            PG8_STAGE(PG8_SB(0, 1), b2 + hstep, voffB);
            PG8_WAIT_V(6); PG8_BAR; PG8_MMA(1, 1, At, B1); PG8_BAR;
            PG8_LDB(B0, 1, 0); PG8_SCHED; PG8_LDA(At, 1, 0); PG8_STAGE(PG8_SA(0, 1), a2 + hstep, voffA);
            PG8_WAIT_L(8); PG8_BAR; PG8_WAIT_L(0); PG8_MMA(0, 0, At, B0); PG8_BAR; PG8_SCHED;
            PG8_LDB(B1, 1, 1); PG8_STAGE(PG8_SB(1, 0), b3, voffB);
            PG8_BAR; PG8_WAIT_L(0); PG8_MMA(0, 1, At, B1); PG8_BAR;
            PG8_LDA(At, 1, 1); PG8_STAGE(PG8_SA(1, 0), a3, voffA);
            PG8_BAR; PG8_WAIT_L(0); PG8_MMA(1, 0, At, B0); PG8_BAR; PG8_SCHED;
            PG8_STAGE(PG8_SB(1, 1), b3 + hstep, voffB);
            PG8_WAIT_V(6); PG8_BAR; PG8_MMA(1, 1, At, B1); PG8_BAR;
            }
        }
        if constexpr (ALIGN_EPI) { if (wr == 0) PG8_BAR; }
        if constexpr (!Epi::AFTER_DRAIN) { E(acc, cur, wr, wc, fr, fq); S.done(cur); }
        if (!has_next) break;
#pragma unroll
        for (int a = 0; a < 2; ++a)
#pragma unroll
            for (int b = 0; b < 2; ++b)
#pragma unroll
                for (int m = 0; m < 4; ++m)
#pragma unroll
                    for (int n = 0; n < 2; ++n) acc[a][b][m][n] = (f32x4){0.f, 0.f, 0.f, 0.f};
        cur = nxt; cA = nA; cB = nB; ++ui;
        if constexpr (ALIGN_EPI) { if (wr == 1) PG8_BAR; }
    }
    PG8_WAIT_V(0);
    if constexpr (!ALIGN_EPI) { if (wr == 0) PG8_BAR; }
    PG8_BAR;
    if constexpr (Epi::AFTER_DRAIN) { E.fused(acc, cur, wr, wc, fr, fq, lds, wid, lane); S.done(cur); }
#undef PG8_SA
#undef PG8_SB
#undef PG8_STAGE
#undef PG8_LDA
#undef PG8_LDB
#undef PG8_MMA
#undef PG8_WAIT_V
#undef PG8_WAIT_L
#undef PG8_BAR
#undef PG8_SCHED
}
}
using pg8::bf16_t; using pg8::bf16x8; using pg8::f32x4; using pg8::u32x4; using pg8::u32x2; using pg8::cvtpk; using pg8::RMS_EPS; using pg8::LOG2E;
typedef float f32x16 __attribute__((ext_vector_type(16)));
#define LAS __attribute__((address_space(3)))
constexpr int NTHR = 512, NWAVES = 8;
constexpr int BATCH = 2, SEQ = 8192, DM = 1024, M = BATCH * SEQ, DFF = 2816, INW = 3088;
constexpr size_t MiB = 1u << 20;
constexpr size_t WS_BAR = 0;
constexpr size_t WS_QHEAD = 15360;
constexpr size_t WS_ROWSS = 64 * 1024;
constexpr size_t WS_WIN = 2 * MiB;
constexpr size_t WS_WO = 8 * MiB;
constexpr size_t WS_WGU = 10 * MiB;
constexpr size_t WS_WD = 21 * MiB;
constexpr size_t WS_GLR = 27 * MiB;
constexpr size_t WS_DVEC = 28 * MiB;
constexpr size_t WS_XN = 32 * MiB;
constexpr size_t WS_PROJ = 64 * MiB;
constexpr size_t WS_VT = 160 * MiB;
constexpr size_t WS_GVT = 176 * MiB;
constexpr size_t WS_MIX = 192 * MiB;
constexpr size_t WS_ST = 224 * MiB;
constexpr size_t WS_END = 256 * MiB;
constexpr int LDS_BYTES = 147456;

__device__ __forceinline__ float bf2f(bf16_t v) { return __uint_as_float((unsigned)v << 16); }
__device__ __forceinline__ bf16_t f2bf(float f) { return (bf16_t)(cvtpk(f, f) & 0xffffu); }
__device__ __forceinline__ float wave_sum(float v) {
#pragma unroll
    for (int o = 1; o < 64; o <<= 1) v += __shfl_xor(v, o);
    return v;
}
__device__ __forceinline__ float wave_max(float v) {
#pragma unroll
    for (int o = 1; o < 64; o <<= 1) v = fmaxf(v, __shfl_xor(v, o));
    return v;
}
__device__ __forceinline__ int crow(int r, int hi) { return (r & 3) + 8 * (r >> 2) + 4 * hi; }
__device__ __forceinline__ int pi_row(int m) { return (m & ~12) | ((m & 4) << 1) | ((m & 8) >> 1); }
__device__ __forceinline__ bf16x8 pack8(float a0, float a1, float a2, float a3, float a4, float a5, float a6, float a7) {
    u32x4 w; w.x = cvtpk(a0, a1); w.y = cvtpk(a2, a3); w.z = cvtpk(a4, a5); w.w = cvtpk(a6, a7); return __builtin_bit_cast(bf16x8, w);
}

template <int MODE> __device__ __forceinline__ int wrow(int n) {
    if (MODE == 1) { const int pn = n >> 8, L = n & 255; return pn * 256 + ((L >> 5) & 1) * 128 + (L >> 6) * 32 + (L & 31); }
    if (MODE == 2) return (n >> 7) * 256 + (n & 127);
    if (MODE == 3) return (n >> 7) * 256 + 128 + (n & 127);
    return n;
}
template <int MODE> __device__ __forceinline__ void p0_transpose_item(const float* W, int ld, int K, int ncols, bf16_t* WT, const float* gain, LAS float* scr, int item, int lane) {
    const int nblk = ncols / 32, kb = item / nblk, nb = item % nblk, k0 = 64 * kb, n0 = 32 * nb;
    float tv[32];
#pragma unroll
    for (int i = 0; i < 32; ++i) { const int kk = 2 * i + (lane >> 5); tv[i] = W[(size_t)(k0 + kk) * ld + n0 + (lane & 31)]; }
    if (gain) {
#pragma unroll
        for (int i = 0; i < 32; ++i) tv[i] *= gain[k0 + 2 * i + (lane >> 5)];
    }
#pragma unroll
    for (int i = 0; i < 32; ++i) scr[(2 * i + (lane >> 5)) * 33 + (lane & 31)] = tv[i];
    asm volatile("s_waitcnt lgkmcnt(0)" ::: "memory");
    const int c = lane & 7;
#pragma unroll
    for (int j = 0; j < 4; ++j) { const int n = (lane >> 3) + 8 * j; const LAS float* s = scr + (8 * c) * 33 + n;
        u32x4 o; o.x = cvtpk(s[0 * 33], s[1 * 33]); o.y = cvtpk(s[2 * 33], s[3 * 33]); o.z = cvtpk(s[4 * 33], s[5 * 33]); o.w = cvtpk(s[6 * 33], s[7 * 33]);
        *(u32x4*)(WT + (size_t)wrow<MODE>(n0 + n) * K + k0 + 8 * c) = o; }
    asm volatile("s_waitcnt lgkmcnt(0)" ::: "memory");
}
struct P0Args { const float *x, *again, *w_in, *w_out, *fgain, *w_g, *w_u, *w_d; bf16_t *WinT, *WoT, *WguT, *WdT, *XN; float *glr, *rowss; };
__device__ __forceinline__ void p0_prologue(LAS unsigned char* lds, const P0Args& A, int G, int bid) {
    int tid_ = threadIdx.x; asm volatile("" : "+v"(tid_)); const int tid = tid_, lane = tid & 63, wave = __builtin_amdgcn_readfirstlane(tid >> 6);
    LAS float* scr = (LAS float*)(lds + wave * 16384);
    const int gw = bid * NWAVES + wave, NGW = G * NWAVES;
    for (int i = bid * NTHR + tid; i < M; i += G * NTHR) A.rowss[i] = 0.f;
    for (int it = gw; it < 16 * 96; it += NGW) p0_transpose_item<1>(A.w_in, INW, 1024, 3072, A.WinT, nullptr, scr, it, lane);
    __syncthreads();
    LAS float* WtT = (LAS float*)lds;
    { float wv[32];
#pragma unroll
      for (int q = 0; q < 32; ++q) { const int i = tid + NTHR * q; wv[q] = A.w_in[(size_t)(i >> 4) * INW + 3072 + (i & 15)]; }
#pragma unroll
      for (int q = 0; q < 32; ++q) { const int i = tid + NTHR * q; WtT[(i & 15) * 1024 + (i >> 4)] = wv[q]; } }
    __syncthreads();
    f32x4 gnv[4];
#pragma unroll
    for (int j = 0; j < 4; ++j) gnv[j] = ((const f32x4*)A.again)[64 * j + lane];
    for (int m = gw; m < M; m += NGW) {
        const f32x4* xr = (const f32x4*)(A.x + (size_t)m * 1024) + lane;
        f32x4 v[4]; float ss = 0.f;
#pragma unroll
        for (int j = 0; j < 4; ++j) { v[j] = xr[64 * j]; ss += (v[j][0] * v[j][0] + v[j][1] * v[j][1]) + (v[j][2] * v[j][2] + v[j][3] * v[j][3]); }
        const float rstd = rsqrtf(wave_sum(ss) * (1.0f / 1024.0f) + RMS_EPS);
        unsigned long long* o8 = (unsigned long long*)(A.XN + (size_t)m * 1024) + lane;
#pragma unroll
        for (int j = 0; j < 4; ++j) { const f32x4 g = gnv[j]; v[j] = v[j] * rstd * g;
            o8[64 * j] = (unsigned long long)cvtpk(v[j][0], v[j][1]) | ((unsigned long long)cvtpk(v[j][2], v[j][3]) << 32); }
        float p[16];
#pragma unroll
        for (int r = 0; r < 16; ++r) { float a = 0.f;
#pragma unroll
            for (int j = 0; j < 4; ++j) { const f32x4 w = *(const LAS f32x4*)(WtT + r * 1024 + 256 * j + 4 * lane); a += (v[j][0] * w[0] + v[j][1] * w[1]) + (v[j][2] * w[2] + v[j][3] * w[3]); }
            p[r] = a; if (r & 1) asm volatile("" ::: "memory"); }
#pragma unroll
        for (int i = 0; i < 8; ++i) { const bool up = lane & 1; const float send = up ? p[i] : p[i + 8], keep = up ? p[i + 8] : p[i]; p[i] = keep + __shfl_xor(send, 1); }
#pragma unroll
        for (int i = 0; i < 4; ++i) { const bool up = lane & 2; const float send = up ? p[i] : p[i + 4], keep = up ? p[i + 4] : p[i]; p[i] = keep + __shfl_xor(send, 2); }
#pragma unroll
        for (int i = 0; i < 2; ++i) { const bool up = lane & 4; const float send = up ? p[i] : p[i + 2], keep = up ? p[i + 2] : p[i]; p[i] = keep + __shfl_xor(send, 4); }
        { const bool up = lane & 8; const float send = up ? p[0] : p[1], keep = up ? p[1] : p[0]; p[0] = keep + __shfl_xor(send, 8); }
        p[0] += __shfl_xor(p[0], 16); p[0] += __shfl_xor(p[0], 32);
        if (lane < 16) { const int r = 8 * (lane & 1) + 4 * ((lane >> 1) & 1) + 2 * ((lane >> 2) & 1) + ((lane >> 3) & 1); A.glr[(size_t)m * 16 + r] = p[0]; }
    }
}

constexpr int LW_O = 16 * 32, LW_G = 16 * 88, LW_D = 44 * 32, LW_ITEMS = LW_O + 2 * LW_G + LW_D, LW_BLOCK_ITEMS = LW_ITEMS / 8;
static_assert(LW_ITEMS % 8 == 0, "late-weight pieces come in groups of eight");
__device__ __forceinline__ void late_weights_item(LAS unsigned char* lds, const P0Args& A, int bi) {
    int tid_ = threadIdx.x; asm volatile("" : "+v"(tid_)); const int lane = tid_ & 63, wave = __builtin_amdgcn_readfirstlane(tid_ >> 6);
    LAS float* scr = (LAS float*)(lds + wave * 16384);
    int r = bi * 8 + wave;
    if (r < LW_O) { p0_transpose_item<0>(A.w_out, 1024, 1024, 1024, A.WoT, nullptr, scr, r, lane); return; } r -= LW_O;
    if (r < LW_G) { p0_transpose_item<2>(A.w_g, DFF, 1024, DFF, A.WguT, A.fgain, scr, r, lane); return; } r -= LW_G;
    if (r < LW_G) { p0_transpose_item<3>(A.w_u, DFF, 1024, DFF, A.WguT, A.fgain, scr, r, lane); return; } r -= LW_G;
    p0_transpose_item<0>(A.w_d, 1024, DFF, 1024, A.WdT, nullptr, scr, r, lane);
}
constexpr int RS = 144;
constexpr int G1_GLR = 0, G1_TOT = 4096, G1_QT = 6144, G1_KT = G1_QT + 64 * RS, G1_KD = G1_KT + 64 * RS, G1_VT = G1_KD + 64 * RS;
struct GlaArgs { const bf16_t* proj; const bf16_t* gvt; const float* glr; const float* w_up; const float* b_gate; bf16_t* QT; float* OINTRA; float* ST; float* dvec; };
__device__ __forceinline__ void gla_chunk_load(const GlaArgs& A, int task, int tid, int lane, int wid, float (&g)[2], u32x4 (&v)[2], unsigned (&qv)[8], unsigned (&kv)[8]) {
    const int bh = task >> 7, c = task & 127, b = bh >> 2, h = bh & 3; const int tok0 = b * SEQ + c * 64;
#pragma unroll
    for (int i = 0; i < 2; ++i) g[i] = A.glr[(size_t)tok0 * 16 + tid + NTHR * i];
#pragma unroll
    for (int i = 0; i < 2; ++i) { const int idx = tid + NTHR * i, row = idx >> 3, ch = idx & 7; v[i] = *(const u32x4*)(A.gvt + ((size_t)(bh * 128 + row)) * SEQ + c * 64 + ch * 8); }
#pragma unroll
    for (int i = 0; i < 8; ++i) { const bf16_t* p = A.proj + (size_t)(tok0 + 8 * wid + i) * 3072 + 1536 + h * 64 + lane; qv[i] = (unsigned)p[0]; kv[i] = (unsigned)p[256]; }
}
__device__ __forceinline__ void gla_chunk_body(LAS unsigned char* lds, const GlaArgs& A, int task, int tid, int lane, int wid, const float (&g)[2], const u32x4 (&v)[2], const unsigned (&qr)[8], const unsigned (&kr)[8], const float (&wup)[16], float bias) {
    const int r32 = lane & 31, hi = lane >> 5;
    LAS float* glrS = (LAS float*)(lds + G1_GLR); LAS float* tot = (LAS float*)(lds + G1_TOT);
    {
#pragma unroll
        for (int i = 0; i < 2; ++i) glrS[tid + NTHR * i] = g[i];
#pragma unroll
        for (int i = 0; i < 2; ++i) { const int idx = tid + NTHR * i, row = idx >> 3, ch = idx & 7; *(LAS u32x4*)(lds + G1_VT + row * RS + ch * 16) = v[i]; }
        __syncthreads();
        float cum[8]; float run = 0.f;
#pragma unroll
        for (int i = 0; i < 8; ++i) { const int t = 8 * wid + i; float z = bias;
#pragma unroll
            for (int r = 0; r < 16; ++r) z += glrS[t * 16 + r] * wup[r];
            const float y = -z; const float sp = fmaxf(y, 0.f) + log1pf(__expf(-fabsf(y)));
            run -= sp * (1.0f / 16.0f); cum[i] = run; }
        tot[wid * 64 + lane] = run;
        __syncthreads();
        float prefix = 0.f, total = 0.f;
#pragma unroll
        for (int w = 0; w < 8; ++w) { const float tv = tot[w * 64 + lane]; total += tv; if (w < wid) prefix += tv; }
        float kd[8];
#pragma unroll
        for (int i = 0; i < 8; ++i) { const int t = 8 * wid + i; const float bb = prefix + cum[i]; const float qvi = __uint_as_float(qr[i] << 16), kvi = __uint_as_float(kr[i] << 16);
            const bf16_t qt = f2bf(qvi * __expf(bb)), kt = f2bf(kvi * __expf(-bb)); kd[i] = kvi * __expf(total - bb);
            *(LAS bf16_t*)(lds + G1_QT + t * RS + lane * 2) = qt; *(LAS bf16_t*)(lds + G1_KT + t * RS + lane * 2) = kt;
            A.QT[(size_t)task * 4096 + t * 64 + lane] = qt; }
        *(LAS bf16x8*)(lds + G1_KD + lane * RS + wid * 16) = pack8(kd[0], kd[1], kd[2], kd[3], kd[4], kd[5], kd[6], kd[7]);
        if (wid == 0) A.dvec[task * 64 + lane] = __expf(total);
        __syncthreads();
        const int tb = wid & 1, vb = wid >> 1;
        f32x16 o = {};
#pragma unroll
        for (int sb = 0; sb < 2; ++sb) {
            if (sb <= tb) {
                f32x16 X = {};
#pragma unroll
                for (int ks = 0; ks < 4; ++ks) {
                    const bf16x8 a = *(const LAS bf16x8*)(lds + G1_KT + (32 * sb + pi_row(r32)) * RS + (16 * ks + 8 * hi) * 2);
                    const bf16x8 bq = *(const LAS bf16x8*)(lds + G1_QT + (32 * tb + r32) * RS + (16 * ks + 8 * hi) * 2);
                    X = __builtin_amdgcn_mfma_f32_32x32x16_bf16(a, bq, X, 0, 0, 0);
                }
                if (sb == tb) {
#pragma unroll
                    for (int r = 0; r < 16; ++r) { if ((16 * (r >> 3) + (r & 7)) > r32 - 8 * hi) X[r] = 0.f; }
                }
                const bf16x8 P0 = pack8(X[0], X[1], X[2], X[3], X[4], X[5], X[6], X[7]), P1 = pack8(X[8], X[9], X[10], X[11], X[12], X[13], X[14], X[15]);
                const bf16x8 v0 = *(const LAS bf16x8*)(lds + G1_VT + (32 * vb + r32) * RS + (32 * sb + 8 * hi) * 2);
                const bf16x8 v1 = *(const LAS bf16x8*)(lds + G1_VT + (32 * vb + r32) * RS + (32 * sb + 16 + 8 * hi) * 2);
                o = __builtin_amdgcn_mfma_f32_32x32x16_bf16(P0, v0, o, 0, 0, 0);
                o = __builtin_amdgcn_mfma_f32_32x32x16_bf16(P1, v1, o, 0, 0, 0);
            }
        }
        f32x4* op = (f32x4*)(A.OINTRA + (size_t)task * 8192 + (tb * 4 + vb) * 1024 + lane * 16);
#pragma unroll
        for (int q4 = 0; q4 < 4; ++q4) op[q4] = (f32x4){o[4 * q4], o[4 * q4 + 1], o[4 * q4 + 2], o[4 * q4 + 3]};
        f32x16 ut = {};
#pragma unroll
        for (int ks = 0; ks < 4; ++ks) {
            const bf16x8 a = *(const LAS bf16x8*)(lds + G1_VT + (32 * vb + r32) * RS + (16 * ks + 8 * hi) * 2);
            const bf16x8 bk = *(const LAS bf16x8*)(lds + G1_KD + (32 * tb + r32) * RS + (16 * ks + 8 * hi) * 2);
            ut = __builtin_amdgcn_mfma_f32_32x32x16_bf16(a, bk, ut, 0, 0, 0);
        }
        float* sp = A.ST + (size_t)task * 8192 + 32 * tb + r32;
#pragma unroll
        for (int r = 0; r < 16; ++r) sp[(32 * vb + crow(r, hi)) * 64] = ut[r];
        __syncthreads();
    }
}
__device__ __forceinline__ void gla_chunk_quad(LAS unsigned char* lds, const GlaArgs& A, int task0) {
    int tid_ = threadIdx.x; asm volatile("" : "+v"(tid_)); const int tid = tid_, lane = tid & 63, wid = __builtin_amdgcn_readfirstlane(tid >> 6);
    const int h = (task0 >> 7) & 3;
    float gA[2], gB[2], gC[2], gD[2]; u32x4 vA[2], vB[2], vC[2], vD[2]; unsigned qA[8], kA[8], qB[8], kB[8], qC[8], kC[8], qD[8], kD[8];
    gla_chunk_load(A, task0, tid, lane, wid, gA, vA, qA, kA);
    gla_chunk_load(A, task0 + 1, tid, lane, wid, gB, vB, qB, kB);
    gla_chunk_load(A, task0 + 2, tid, lane, wid, gC, vC, qC, kC);
    gla_chunk_load(A, task0 + 3, tid, lane, wid, gD, vD, qD, kD);
    float wup[16];
#pragma unroll
    for (int r = 0; r < 16; ++r) wup[r] = A.w_up[r * 256 + h * 64 + lane];
    const float bias = A.b_gate[h * 64 + lane];
    gla_chunk_body(lds, A, task0, tid, lane, wid, gA, vA, qA, kA, wup, bias);
    gla_chunk_body(lds, A, task0 + 1, tid, lane, wid, gB, vB, qB, kB, wup, bias);
    gla_chunk_body(lds, A, task0 + 2, tid, lane, wid, gC, vC, qC, kC, wup, bias);
    gla_chunk_body(lds, A, task0 + 3, tid, lane, wid, gD, vD, qD, kD, wup, bias);
}
__device__ __forceinline__ void gla_scan_phase(float* ST, const float* dvec, int G, int bid) {
    int tid_ = threadIdx.x; asm volatile("" : "+v"(tid_));
    for (int gid = bid * NTHR + tid_; gid < 65536; gid += G * NTHR) {
        const int bh = gid >> 13, e = gid & 8191, k = e & 63;
        float* sp = ST + (size_t)bh * 128 * 8192 + e; const float* dp = dvec + bh * 128 * 64 + k;
        float S = 0.f;
        for (int c0 = 0; c0 < 128; c0 += 32) {
            float u[32], d[32];
#pragma unroll
            for (int j = 0; j < 32; ++j) { u[j] = sp[(size_t)(c0 + j) * 8192]; d[j] = dp[(c0 + j) * 64]; }
#pragma unroll
            for (int j = 0; j < 32; ++j) { sp[(size_t)(c0 + j) * 8192] = S; S = d[j] * S + u[j]; }
        }
    }
}
__device__ __forceinline__ void gla_scan_item(float* ST, const float* dvec, int j) {
    int tid_ = threadIdx.x; asm volatile("" : "+v"(tid_));
    {
        const int bh = j >> 4, e = (j & 15) * NTHR + tid_, k = e & 63;
        float* sp = ST + (size_t)bh * 128 * 8192 + e; const float* dp = dvec + bh * 128 * 64 + k;
        float S = 0.f;
        for (int c0 = 0; c0 < 128; c0 += 8) {
            float u[8], d[8];
#pragma unroll
            for (int jj = 0; jj < 8; ++jj) { u[jj] = sp[(size_t)(c0 + jj) * 8192]; d[jj] = dp[(c0 + jj) * 64]; }
#pragma unroll
            for (int jj = 0; jj < 8; ++jj) { sp[(size_t)(c0 + jj) * 8192] = S; S = d[jj] * S + u[jj]; }
        }
    }
}
__device__ __forceinline__ void item_done(unsigned* cnt) {
    if (cnt != nullptr) asm volatile("s_waitcnt vmcnt(0)" ::: "memory");
    __builtin_amdgcn_s_barrier();
    if (threadIdx.x == 0 && cnt != nullptr) { __builtin_amdgcn_fence(__ATOMIC_RELEASE, "agent"); asm volatile("s_waitcnt vmcnt(0)" ::: "memory"); __hip_atomic_fetch_add(cnt, 1u, __ATOMIC_RELAXED, __HIP_MEMORY_SCOPE_AGENT); }
}
__device__ __forceinline__ void item_wait(unsigned* cnt, unsigned want) {
    if (threadIdx.x == 0 && cnt != nullptr) { unsigned spn = 0; while (__hip_atomic_load(cnt, __ATOMIC_RELAXED, __HIP_MEMORY_SCOPE_AGENT) < want) { __builtin_amdgcn_s_sleep(2); if (++spn > (1u << 16)) break; }
        __builtin_amdgcn_fence(__ATOMIC_ACQUIRE, "agent"); asm volatile("s_waitcnt vmcnt(0)" ::: "memory"); }
    __syncthreads();
}
struct Gla3Args { const bf16_t* proj; const bf16_t* QT; const float* OINTRA; const float* ST; const float* ggain; bf16_t* mixed; };
__device__ __forceinline__ void gla_out_task(const Gla3Args& A, int wt) {
    int tid_ = threadIdx.x; asm volatile("" : "+v"(tid_)); const int tid = tid_, lane = tid & 63, r32 = lane & 31, hi = lane >> 5;
    {
        const int task = wt >> 1, tb = wt & 1, bh = task >> 7, c = task & 127, b = bh >> 2, h = bh & 3; const int tok0 = b * SEQ + c * 64 + 32 * tb;
        const bf16_t* grow = A.proj + (size_t)tok0 * 3072 + 2560 + h * 128; bf16_t* mrow = A.mixed + (size_t)tok0 * 1024 + 512 + h * 128;
        unsigned goff = (unsigned)(4 * hi * 3072 + r32), moff = (unsigned)(4 * hi * 1024 + r32); asm volatile("" : "+v"(goff), "+v"(moff));
        float ggv[4];
#pragma unroll
        for (int vb = 0; vb < 4; ++vb) ggv[vb] = A.ggain[32 * vb + r32];
        bf16x8 qa[4];
#pragma unroll
        for (int ks = 0; ks < 4; ++ks) qa[ks] = *(const bf16x8*)(A.QT + (size_t)task * 4096 + (32 * tb + r32) * 64 + 16 * ks + 8 * hi);
        f32x16 acc[4];
        f32x4 sfA[8];
#define G3_SLOAD(DST, VB) do { _Pragma("unroll") for (int ks_ = 0; ks_ < 4; ++ks_) { const float* sp_ = A.ST + (size_t)task * 8192 + (32 * (VB) + r32) * 64 + 16 * ks_ + 8 * hi; \
        DST[2 * ks_] = *(const f32x4*)sp_; DST[2 * ks_ + 1] = *(const f32x4*)(sp_ + 4); } } while (0)
#define G3_MMA(SRC, VB) do { _Pragma("unroll") for (int ks_ = 0; ks_ < 4; ++ks_) { const f32x4 f0 = SRC[2 * ks_], f1 = SRC[2 * ks_ + 1]; \
        acc[VB] = __builtin_amdgcn_mfma_f32_32x32x16_bf16(qa[ks_], pack8(f0[0], f0[1], f0[2], f0[3], f1[0], f1[1], f1[2], f1[3]), acc[VB], 0, 0, 0); } } while (0)
#pragma unroll
        for (int vb = 0; vb < 4; ++vb) {
            const f32x4* op = (const f32x4*)(A.OINTRA + (size_t)task * 8192 + (tb * 4 + vb) * 1024 + lane * 16);
#pragma unroll
            for (int q4 = 0; q4 < 4; ++q4) { const f32x4 t4 = op[q4]; acc[vb][4 * q4] = t4[0]; acc[vb][4 * q4 + 1] = t4[1]; acc[vb][4 * q4 + 2] = t4[2]; acc[vb][4 * q4 + 3] = t4[3]; }
        }
#pragma unroll
        for (int vb = 0; vb < 4; ++vb) { G3_SLOAD(sfA, vb); __builtin_amdgcn_sched_barrier(0); G3_MMA(sfA, vb); __builtin_amdgcn_sched_barrier(0); }
#undef G3_SLOAD
#undef G3_MMA
        bf16_t gt[4][16];
#pragma unroll
        for (int vb = 0; vb < 4; ++vb)
#pragma unroll
            for (int r = 0; r < 16; ++r) gt[vb][r] = grow[goff + (unsigned)(((r & 3) + 8 * (r >> 2)) * 3072 + 32 * vb)];
        float rstd[16];
#pragma unroll
        for (int r = 0; r < 16; ++r) { float ss = 0.f;
#pragma unroll
            for (int vb = 0; vb < 4; ++vb) ss += acc[vb][r] * acc[vb][r];
            rstd[r] = ss; }
#pragma unroll
        for (int o = 1; o < 32; o <<= 1) {
#pragma unroll
            for (int r = 0; r < 16; ++r) rstd[r] += __shfl_xor(rstd[r], o);
            __builtin_amdgcn_sched_barrier(0); }
#pragma unroll
        for (int r = 0; r < 16; ++r) rstd[r] = rsqrtf(rstd[r] * (1.0f / 128.0f) + RMS_EPS);
#pragma unroll
        for (int vb = 0; vb < 4; ++vb) { const float gg = ggv[vb];
#pragma unroll
            for (int r = 0; r < 16; ++r) { const int rr = (r & 3) + 8 * (r >> 2);
                const float gate = bf2f(gt[vb][r]);
                const float sg = gate * __builtin_amdgcn_rcpf(1.0f + __builtin_amdgcn_exp2f(-gate * LOG2E));
                mrow[moff + (unsigned)(rr * 1024 + 32 * vb)] = f2bf(acc[vb][r] * rstd[r] * gg * sg); } }
    }
}
constexpr int AT_K = 0, AT_V = 2 * 64 * RS, AT_STAGE = AT_V + 128 * RS;
constexpr int AT_WSF = 65536;
struct AttnArgs { const bf16_t* proj; const bf16_t* vt; bf16_t* mixed; const float *qg, *kg, *lq1, *lk1, *lq2, *lk2, *dgain; float* parto; float* partl; };
__device__ __forceinline__ int attn_kt0(int h, int qb, float TH) { const float slope2 = exp2f(-2.0f * (float)(h + 1)) * LOG2E; const float v = floorf(((float)(128 * qb - 63) - TH / slope2) * (1.0f / 64.0f)) + 1.0f; return v > 0.f ? (int)v : 0; }
constexpr int SEGT = 64;
__device__ __forceinline__ bool attn_split(int h, int qb, int nt_eff) { return h >= 2 && qb >= 32 && nt_eff > SEGT; }
__device__ __forceinline__ int attn_slot(int b, int h, int qb) { return (b * 2 + (h - 2)) * 32 + (qb - 32); }
__device__ __forceinline__ bool attn_item(LAS unsigned char* lds, const AttnArgs& A, int it, float lam, float M2) {
    int tid_ = threadIdx.x; asm volatile("" : "+v"(tid_)); const int tid = tid_, lane = tid & 63, wid = __builtin_amdgcn_readfirstlane(tid >> 6), r32 = lane & 31, hi = lane >> 5;
    const int g = wid >> 2, w = wid & 3;
    int qb, bh, seg;
    if (it < 384) { qb = 63 - it / 12; const int j = it % 12; if (j < 8) { bh = j; seg = 0; } else { bh = ((j - 8) >> 1) * 4 + 2 + ((j - 8) & 1); seg = 1; } }
    else { const int i2 = it - 384; qb = 31 - (i2 >> 3); bh = i2 & 7; seg = 0; }
    const int b = bh >> 2, h = bh & 3;
    const float TH = 2.0f * M2 + 53.0f;
    const int ntile_all = 2 * qb + 2, kt0 = attn_kt0(h, qb, TH), nt_eff = ntile_all - kt0;
    const bool split = attn_split(h, qb, nt_eff);
    int kt_begin = kt0, kt_end = ntile_all;
    if (split) { const int half = nt_eff >> 1; if (seg == 0) kt_end = kt0 + half; else kt_begin = kt0 + half; }
    else if (seg == 1) return false;
    int kgo[2], klo[2], vgo[2], vlo[2];
#pragma unroll
    for (int i = 0; i < 2; ++i) { const int idx = tid + NTHR * i; const int krow = idx >> 4, kch = idx & 15; kgo[i] = krow * 3072 + kch * 8; klo[i] = AT_K + (kch >> 3) * (64 * RS) + krow * RS + (kch & 7) * 16;
        const int vrow = idx >> 3, vch = idx & 7; vgo[i] = vrow * SEQ + vch * 8; vlo[i] = AT_V + vrow * RS + vch * 16; }
    {
        const float slope2 = exp2f(-2.0f * (float)(h + 1)) * LOG2E;
        const bf16_t* Kg = A.proj + (size_t)b * SEQ * 3072 + 512 + h * 128;
        const bf16_t* Vg = A.vt + (size_t)bh * 128 * SEQ;
        {
            const int q0 = qb * 128;
            const int qpos = q0 + 32 * w + r32;
            bf16x8 qf[4];
#pragma unroll
            for (int ds = 0; ds < 4; ++ds) qf[ds] = *(const bf16x8*)(A.proj + ((size_t)b * SEQ + qpos) * 3072 + h * 128 + g * 64 + 16 * ds + 8 * hi);
            u32x4 kr[2], vr[2];
#pragma unroll
            for (int i = 0; i < 2; ++i) { kr[i] = *(const u32x4*)(Kg + (size_t)(64 * kt_begin) * 3072 + kgo[i]); vr[i] = *(const u32x4*)(Vg + 64 * kt_begin + vgo[i]); }
#pragma unroll
            for (int i = 0; i < 2; ++i) { *(LAS u32x4*)(lds + klo[i]) = kr[i]; *(LAS u32x4*)(lds + vlo[i]) = vr[i]; }
            __syncthreads();
            f32x16 O[4]; O[0] = f32x16{}; O[1] = f32x16{}; O[2] = f32x16{}; O[3] = f32x16{};
            float l = 0.f;
            float cr8[8];
#pragma unroll
            for (int j = 0; j < 8; ++j) cr8[j] = -slope2 * (float)(qpos - (8 * hi + j)) - M2;
            for (int t = kt_begin; t < kt_end; ++t) {
                const int k0 = 64 * t; const bool more = t + 1 < kt_end;
                if (more) {
#pragma unroll
                    for (int i = 0; i < 2; ++i) { kr[i] = *(const u32x4*)(Kg + (size_t)(k0 + 64) * 3072 + kgo[i]); vr[i] = *(const u32x4*)(Vg + (k0 + 64) + vgo[i]); }
                }
                const LAS unsigned char* sp = lds + ((t - kt_begin) & 1) * AT_STAGE;
                if (k0 <= q0 + 32 * w + 31) {
                    bf16x8 kf[8];
#pragma unroll
                    for (int blk = 0; blk < 2; ++blk)
#pragma unroll
                        for (int ds = 0; ds < 4; ++ds) kf[blk * 4 + ds] = *(const LAS bf16x8*)(sp + AT_K + g * (64 * RS) + (32 * blk + pi_row(r32)) * RS + (16 * ds + 8 * hi) * 2);
                    __builtin_amdgcn_sched_barrier(0);
                    f32x16 S[2];
#pragma unroll
                    for (int blk = 0; blk < 2; ++blk) {
                        const float off0 = slope2 * (float)(k0 + 32 * blk), off1 = slope2 * (float)(k0 + 32 * blk + 16);
#pragma unroll
                        for (int r = 0; r < 16; ++r) S[blk][r] = cr8[r & 7] + ((r >> 3) ? off1 : off0);
                    }
#pragma unroll
                    for (int ds = 0; ds < 4; ++ds)
#pragma unroll
                        for (int blk = 0; blk < 2; ++blk) S[blk] = __builtin_amdgcn_mfma_f32_32x32x16_bf16(kf[blk * 4 + ds], qf[ds], S[blk], 0, 0, 0);
                    bf16x8 vfA[4], vfB[4];
#pragma unroll
                    for (int ks = 0; ks < 4; ++ks) vfA[ks] = *(const LAS bf16x8*)(sp + AT_V + r32 * RS + (16 * ks + 8 * hi) * 2);
                    __builtin_amdgcn_sched_barrier(0);
                    const bool needmask = k0 + 63 > q0 + 32 * w;
                    const int dlim = qpos - k0 - 8 * hi;
                    float ls = 0.f;
                    if (needmask) {
#pragma unroll
                        for (int blk = 0; blk < 2; ++blk)
#pragma unroll
                            for (int r = 0; r < 16; ++r) { float pv = __builtin_amdgcn_exp2f(S[blk][r]);
                                if ((32 * blk + 16 * (r >> 3) + (r & 7)) > dlim) pv = 0.f;
                                S[blk][r] = pv; ls += pv; }
                    } else {
                        float ls1 = 0.f;
#pragma unroll
                        for (int blk = 0; blk < 2; ++blk)
#pragma unroll
                            for (int r = 0; r < 16; r += 2) { const float p0 = __builtin_amdgcn_exp2f(S[blk][r]), p1 = __builtin_amdgcn_exp2f(S[blk][r + 1]); S[blk][r] = p0; S[blk][r + 1] = p1; ls += p0; ls1 += p1; }
                        ls += ls1;
                    }
                    l += ls;
                    bf16x8 P[4];
#pragma unroll
                    for (int blk = 0; blk < 2; ++blk) { P[2 * blk] = pack8(S[blk][0], S[blk][1], S[blk][2], S[blk][3], S[blk][4], S[blk][5], S[blk][6], S[blk][7]);
                        P[2 * blk + 1] = pack8(S[blk][8], S[blk][9], S[blk][10], S[blk][11], S[blk][12], S[blk][13], S[blk][14], S[blk][15]); }
#pragma unroll
                    for (int vb = 0; vb < 4; ++vb) {
                        if (vb < 3) {
#pragma unroll
                            for (int ks = 0; ks < 4; ++ks) vfB[ks] = *(const LAS bf16x8*)(sp + AT_V + (32 * (vb + 1) + r32) * RS + (16 * ks + 8 * hi) * 2);
                        }
                        __builtin_amdgcn_sched_barrier(0);
#pragma unroll
                        for (int ks = 0; ks < 4; ++ks) O[vb] = __builtin_amdgcn_mfma_f32_32x32x16_bf16(P[ks], vfA[ks], O[vb], 0, 0, 0);
                        __builtin_amdgcn_sched_barrier(0);
#pragma unroll
                        for (int ks = 0; ks < 4; ++ks) vfA[ks] = vfB[ks];
                    }
                }
                if (more) { LAS unsigned char* dp = lds + ((t + 1 - kt_begin) & 1) * AT_STAGE;
#pragma unroll
                    for (int i = 0; i < 2; ++i) { *(LAS u32x4*)(dp + klo[i]) = kr[i]; *(LAS u32x4*)(dp + vlo[i]) = vr[i]; } }
                __syncthreads();
            }
            l += __shfl_xor(l, 32);
            if (split) {
                const int slot = attn_slot(b, h, qb); const size_t pidx = (size_t)((slot * 2 + seg) * 2 + g) * 4 + w;
                float* po = A.parto + pidx * 4096 + lane;
#pragma unroll
                for (int vb = 0; vb < 4; ++vb)
#pragma unroll
                    for (int r = 0; r < 16; ++r) po[(vb * 16 + r) * 64] = O[vb][r];
                if (hi == 0) A.partl[pidx * 32 + r32] = l;
                return true;
            }
            float dgv[4];
#pragma unroll
            for (int vb = 0; vb < 4; ++vb) dgv[vb] = A.dgain[32 * vb + r32] * 0.8f;
            LAS float* wsf = (LAS float*)(lds + AT_WSF) + wid * 32;
            if (hi == 0) wsf[r32] = 1.0f / l;
            asm volatile("s_waitcnt lgkmcnt(0)" ::: "memory");
            float rl[16];
#pragma unroll
            for (int r = 0; r < 16; ++r) rl[r] = wsf[crow(r, hi)];
            LAS float* X = (LAS float*)lds + (size_t)w * 64 * 64 + lane;
            if (g == 1) {
#pragma unroll
                for (int vb = 0; vb < 4; ++vb)
#pragma unroll
                    for (int r = 0; r < 16; ++r) X[(vb * 16 + r) * 64] = lam * O[vb][r] * rl[r];
            }
            __syncthreads();
            if (g == 0) {
                float rstd[16];
#pragma unroll
                for (int r = 0; r < 16; ++r) { float ss = 0.f;
#pragma unroll
                    for (int vb = 0; vb < 4; ++vb) { const float o = O[vb][r] * rl[r] - X[(vb * 16 + r) * 64]; O[vb][r] = o; ss += o * o; }
                    rstd[r] = ss; }
#pragma unroll
                for (int o = 1; o < 32; o <<= 1) {
#pragma unroll
                    for (int r = 0; r < 16; ++r) rstd[r] += __shfl_xor(rstd[r], o);
                    __builtin_amdgcn_sched_barrier(0); }
#pragma unroll
                for (int r = 0; r < 16; ++r) rstd[r] = rsqrtf(rstd[r] * (1.0f / 128.0f) + RMS_EPS);
                bf16_t* mrow = A.mixed + ((size_t)b * SEQ + q0 + 32 * w) * 1024 + h * 128;
                unsigned loff = (unsigned)(4 * hi * 1024 + r32); asm volatile("" : "+v"(loff));
#pragma unroll
                for (int vb = 0; vb < 4; ++vb) { const float dg = dgv[vb];
#pragma unroll
                    for (int r = 0; r < 16; ++r) mrow[loff + (unsigned)(((r & 3) + 8 * (r >> 2)) * 1024 + 32 * vb)] = f2bf(O[vb][r] * rstd[r] * dg); }
            }
            __syncthreads();
        }
    }
    return false;
}
__device__ __forceinline__ void attn_finalize(const AttnArgs& A, int wt, float lam, float M2) {
    int tid_ = threadIdx.x; asm volatile("" : "+v"(tid_)); const int lane = tid_ & 63, r32 = lane & 31, hi = lane >> 5;
    const int slot = wt >> 2, w = wt & 3; const int b = slot >> 6, h = 2 + ((slot >> 5) & 1), qb = 32 + (slot & 31);
    const float TH = 2.0f * M2 + 53.0f; const int nt_eff = 2 * qb + 2 - attn_kt0(h, qb, TH);
    if (!attn_split(h, qb, nt_eff)) return;
    float rl[2][16];
#pragma unroll
    for (int g = 0; g < 2; ++g)
#pragma unroll
        for (int r = 0; r < 16; ++r) { const int q = crow(r, hi); rl[g][r] = 1.0f / (A.partl[((size_t)((slot * 2 + 0) * 2 + g) * 4 + w) * 32 + q] + A.partl[((size_t)((slot * 2 + 1) * 2 + g) * 4 + w) * 32 + q]); }
    float dgv[4];
#pragma unroll
    for (int vb = 0; vb < 4; ++vb) dgv[vb] = A.dgain[32 * vb + r32];
    float o[4][16]; float rstd[16];
#pragma unroll
    for (int r = 0; r < 16; ++r) { float ss = 0.f;
#pragma unroll
        for (int vb = 0; vb < 4; ++vb) { const int e = (vb * 16 + r) * 64 + lane;
            const float o0 = A.parto[((size_t)((slot * 2 + 0) * 2 + 0) * 4 + w) * 4096 + e] + A.parto[((size_t)((slot * 2 + 1) * 2 + 0) * 4 + w) * 4096 + e];
            const float o1 = A.parto[((size_t)((slot * 2 + 0) * 2 + 1) * 4 + w) * 4096 + e] + A.parto[((size_t)((slot * 2 + 1) * 2 + 1) * 4 + w) * 4096 + e];
            const float v = o0 * rl[0][r] - lam * o1 * rl[1][r]; o[vb][r] = v; ss += v * v; }
        rstd[r] = ss; }
#pragma unroll
    for (int x = 1; x < 32; x <<= 1) {
#pragma unroll
        for (int r = 0; r < 16; ++r) rstd[r] += __shfl_xor(rstd[r], x);
        __builtin_amdgcn_sched_barrier(0); }
#pragma unroll
    for (int r = 0; r < 16; ++r) rstd[r] = rsqrtf(rstd[r] * (1.0f / 128.0f) + RMS_EPS);
    bf16_t* mrow = A.mixed + ((size_t)b * SEQ + qb * 128 + 32 * w) * 1024 + h * 128;
    unsigned loff = (unsigned)(4 * hi * 1024 + r32); asm volatile("" : "+v"(loff));
#pragma unroll
    for (int vb = 0; vb < 4; ++vb) { const float dg = dgv[vb] * 0.8f;
#pragma unroll
        for (int r = 0; r < 16; ++r) mrow[loff + (unsigned)(((r & 3) + 8 * (r >> 2)) * 1024 + 32 * vb)] = f2bf(o[vb][r] * rstd[r] * dg); }
}
__device__ __forceinline__ void attn_consts(const AttnArgs& A, float& lam, float& M2) {
    int tid_ = threadIdx.x; asm volatile("" : "+v"(tid_)); const int lane = tid_ & 63;
    lam = __expf(wave_sum(A.lq1[lane] * A.lk1[lane])) - __expf(wave_sum(A.lq2[lane] * A.lk2[lane])) + 0.2f;
    M2 = 8.0f * wave_max(fabsf(A.qg[lane])) * wave_max(fabsf(A.kg[lane])) * LOG2E;
    lam = __uint_as_float(__builtin_amdgcn_readfirstlane(__float_as_uint(lam))); M2 = __uint_as_float(__builtin_amdgcn_readfirstlane(__float_as_uint(M2)));
}
#define XB_TMO      128
#define XB_XCNT(j)  (256  + 64 * (j))
#define XB_XSUB(j)  (1280 + 64 * (j))
#define XB_XGEN(j)  (2304 + 64 * (j))
#define XB_TOP      3328
#define XB_TOPGEN   3392
#define XCD_BAR_WORDS 3456
#define XB_SPIN_CAP (1u << 18)

__device__ __forceinline__ unsigned xb_ld(unsigned* p)              { return __hip_atomic_load(p, __ATOMIC_RELAXED, __HIP_MEMORY_SCOPE_AGENT); }
__device__ __forceinline__ unsigned xb_add(unsigned* p, unsigned v) { return __hip_atomic_fetch_add(p, v, __ATOMIC_RELAXED, __HIP_MEMORY_SCOPE_AGENT); }
__device__ __forceinline__ unsigned xb_xcc_id() { return (unsigned)__builtin_amdgcn_s_getreg((3 << 11) | 20) & 0xFu; }
#define XB_SPIN(cond, bar) do { unsigned _sp = 0; while (cond) { __builtin_amdgcn_s_sleep(1); \
    if ((++_sp & 255u) == 0u) { if (xb_ld(&(bar)[XB_TMO])) break; if (_sp > XB_SPIN_CAP) { atomicAdd(&(bar)[XB_TMO], 1u); break; } } } } while (0)

struct XcdBarrier {
    unsigned* bar; unsigned x;
    volatile LAS unsigned* st;
};

__device__ __forceinline__ XcdBarrier xcd_barrier_post(unsigned* bar, volatile LAS unsigned* st) {
    XcdBarrier b; b.bar = bar; b.x = xb_xcc_id(); b.st = st;
    if (threadIdx.x == 0) (void)xb_add(&bar[XB_XCNT(b.x)], 1u);
    return b;
}
__device__ __forceinline__ void xcd_barrier_complete(unsigned* bar, unsigned x, unsigned& nloc, unsigned& nx) {
    const unsigned G = gridDim.x * gridDim.y * gridDim.z;
    unsigned sum, cnt, mine, sp = 0u;
    for (;;) {
        sum = 0u; cnt = 0u; mine = 0u;
#pragma unroll
        for (unsigned j = 0; j < 16; ++j) { const unsigned c = xb_ld(&bar[XB_XCNT(j)]); sum += c; cnt += (c > 0u) ? 1u : 0u; mine = (j == x) ? c : mine; }
        if (sum == G) break;
        __builtin_amdgcn_s_sleep(1);
        if ((++sp & 255u) == 0u) { if (xb_ld(&bar[XB_TMO])) break; if (sp > XB_SPIN_CAP) { atomicAdd(&bar[XB_TMO], 1u); break; } }
    }
    nloc = mine > 0u ? mine : 1u; nx = cnt > 0u ? cnt : 1u;
}

__device__ __forceinline__ void xcd_barrier(const XcdBarrier& b) {
    asm volatile("s_waitcnt vmcnt(0)" ::: "memory");
    __syncthreads();
    if (threadIdx.x == 0) {
        unsigned* bar = b.bar;
        __builtin_amdgcn_s_waitcnt(0);
        unsigned nloc = b.st[0], nx = b.st[1];
        if (nloc == 0u) { xcd_barrier_complete(bar, b.x, nloc, nx); b.st[0] = nloc; b.st[1] = nx; }
        const unsigned old = xb_add(&bar[XB_XSUB(b.x)], 1u);
        const unsigned gen = old / nloc;
        if (old + 1u == (gen + 1u) * nloc) {
            __builtin_amdgcn_fence(__ATOMIC_RELEASE, "agent");
            asm volatile("s_waitcnt vmcnt(0)" ::: "memory");
            const unsigned og = xb_add(&bar[XB_TOP], 1u);
            const unsigned tg = og / nx;
            if (og + 1u == (tg + 1u) * nx) xb_add(&bar[XB_TOPGEN], 1u);
            else XB_SPIN(xb_ld(&bar[XB_TOPGEN]) == tg, bar);
            __builtin_amdgcn_fence(__ATOMIC_ACQUIRE, "agent");
            xb_add(&bar[XB_XGEN(b.x)], 1u);
            asm volatile("s_waitcnt vmcnt(0)" ::: "memory");
        } else {
            XB_SPIN(xb_ld(&bar[XB_XGEN(b.x)]) == gen, bar);
            __builtin_amdgcn_fence(__ATOMIC_ACQUIRE, "agent");
            asm volatile("s_waitcnt vmcnt(0)" ::: "memory");
        }
    }
    __syncthreads();
}

constexpr int MISC_OFF = 131072 + 320;
#ifndef MK_N_LAUNCHES
#define MK_N_LAUNCHES 1
#endif
constexpr int NPHASE = 9;
struct Args { const float* in[18]; float* out; unsigned char* ws; int ph_lo, ph_hi; };
__global__ void __launch_bounds__(NTHR, 2) fwd_megakernel(Args a) {
    extern __shared__ __attribute__((aligned(16))) unsigned char lds_raw[];
    LAS unsigned char* lds = (LAS unsigned char*)lds_raw;
    cg::grid_group grid = cg::this_grid();
    const int G = gridDim.x, bid = blockIdx.x;
    unsigned char* ws = a.ws;
    volatile LAS unsigned* MISC = (volatile LAS unsigned*)(lds + MISC_OFF);
    if (threadIdx.x < 32) MISC[threadIdx.x] = 0u;
    __syncthreads();
    XcdBarrier bar = xcd_barrier_post((unsigned*)(ws + WS_BAR), MISC + 8);
    if (a.ph_lo < 0) grid.sync();
    const float* x = a.in[0];
    bf16_t* WinT = (bf16_t*)(ws + WS_WIN); bf16_t* WoT = (bf16_t*)(ws + WS_WO); bf16_t* WguT = (bf16_t*)(ws + WS_WGU); bf16_t* WdT = (bf16_t*)(ws + WS_WD);
    float* glr = (float*)(ws + WS_GLR); float* dvec = (float*)(ws + WS_DVEC); float* rowss = (float*)(ws + WS_ROWSS);
    bf16_t* XN = (bf16_t*)(ws + WS_XN); bf16_t* PROJ = (bf16_t*)(ws + WS_PROJ); bf16_t* VT = (bf16_t*)(ws + WS_VT); bf16_t* GVT = (bf16_t*)(ws + WS_GVT);
    bf16_t* MIX = (bf16_t*)(ws + WS_MIX); float* ST = (float*)(ws + WS_ST);
    float* OINTRA = a.out; bf16_t* QT = (bf16_t*)((unsigned char*)a.out + 32 * MiB);
    bf16_t* HB = XN; bf16_t* HID = PROJ;
    float* PARTO = (float*)(ws + WS_XN); float* PARTL = (float*)((unsigned char*)a.out + 40 * MiB);
    const int lo = a.ph_lo, hi = a.ph_hi;
#define IN(k) (lo <= (k) && (k) < hi)
#ifndef REPEAT_MASK
#define REPEAT_MASK 0
#endif
#define REP(k) (((REPEAT_MASK >> (k)) & 1) ? 2 : 1)
#define SEAM(k) do { if (IN(k) && IN((k) + 1)) xcd_barrier(bar); } while (0)
    if (IN(0)) for (int rep_ = 0; rep_ < REP(0); ++rep_) { P0Args P{x, a.in[1], a.in[2], a.in[13], a.in[14], a.in[15], a.in[16], a.in[17], WinT, WoT, WguT, WdT, XN, glr, rowss}; p0_prologue(lds, P, G, bid); }
    SEAM(0);
    if (IN(1)) for (int rep_ = 0; rep_ < REP(1); ++rep_) { pg8::Gemm g{XN, WinT, M, 3072, 1024}; pg8::StaticOrder S; S.init(M, 3072, G, bid);
        pg8::EpiInProj E{PROJ, VT, GVT, a.in[3], a.in[4]};
        pg8::gemm_phase<pg8::EpiInProj, pg8::StaticOrder, true, true>(lds, g, S, E); }
    SEAM(1);
    if (IN(2)) { GlaArgs GA{PROJ, GVT, glr, a.in[10], a.in[11], QT, OINTRA, ST, dvec}; Gla3Args GB{PROJ, QT, OINTRA, ST, a.in[12], MIX};
        AttnArgs AA{PROJ, VT, MIX, a.in[3], a.in[4], a.in[5], a.in[6], a.in[7], a.in[8], a.in[9], PARTO, PARTL};
        P0Args PW{x, a.in[1], a.in[2], a.in[13], a.in[14], a.in[15], a.in[16], a.in[17], WinT, WoT, WguT, WdT, XN, glr, rowss};
        float lam, M2; attn_consts(AA, lam, M2);
        unsigned* qhead = (unsigned*)(ws + WS_QHEAD); unsigned* g1done = qhead + 64; unsigned* scandone = qhead + 128; unsigned* splitdone = qhead + 192;
        const int wid_ = __builtin_amdgcn_readfirstlane(threadIdx.x >> 6);
        int nsplit;
        { const float TH = 2.0f * M2 + 53.0f; const int l_ = threadIdx.x & 63; float sp_ = 0.f;
#pragma unroll
          for (int q_ = 0; q_ < 2; ++q_) { const int t_ = l_ + 64 * q_; const int h_ = 2 + ((t_ >> 5) & 1), qb_ = 32 + (t_ & 31); sp_ += attn_split(h_, qb_, 2 * qb_ + 2 - attn_kt0(h_, qb_, TH)) ? 1.f : 0.f; }
          nsplit = __builtin_amdgcn_readfirstlane((int)(wave_sum(sp_) + 0.5f)); }
        constexpr int Q_A1 = 256, Q_SC = Q_A1 + 256, Q_A2 = Q_SC + 128, Q_FN = Q_A2 + 384, Q_G3 = Q_FN + 64, Q_LW = Q_G3 + 256, Q_END = Q_LW + LW_BLOCK_ITEMS;
        unsigned nxt_ = 0u;
        if (threadIdx.x == 0) nxt_ = __hip_atomic_fetch_add(qhead, 1u, __ATOMIC_RELAXED, __HIP_MEMORY_SCOPE_AGENT);
        for (;;) {
            if (threadIdx.x == 0) MISC[0] = nxt_;
            __syncthreads();
            const int it = __builtin_amdgcn_readfirstlane((int)MISC[0]);
            __syncthreads();
            if (it >= Q_END) break;
            const int ty = it < Q_A1 ? 0 : it < Q_SC ? 1 : it < Q_A2 ? 2 : it < Q_FN ? 1 : it < Q_G3 ? 3 : it < Q_LW ? 4 : 5;
            unsigned* wcnt = ty == 2 ? g1done : ty == 3 ? splitdone : ty == 4 ? scandone : nullptr;
            const unsigned want = ty == 2 ? 256u : ty == 3 ? 2u * (unsigned)nsplit : 128u;
            item_wait(wcnt, want);
            unsigned* dcnt = nullptr;
            if (ty == 0) { gla_chunk_quad(lds, GA, 4 * it); dcnt = g1done; }
            else if (ty == 1) { const int ai = it < Q_SC ? it - Q_A1 : it - Q_A2 + 256; if (attn_item(lds, AA, ai, lam, M2)) dcnt = splitdone; }
            else if (ty == 2) { gla_scan_item(ST, dvec, it - Q_SC); dcnt = scandone; }
            else if (ty == 3) attn_finalize(AA, (it - Q_FN) * NWAVES + wid_, lam, M2);
            else if (ty == 4) gla_out_task(GB, (it - Q_G3) * NWAVES + wid_);
            else late_weights_item(lds, PW, it - Q_LW);
            if (threadIdx.x == 0) nxt_ = __hip_atomic_fetch_add(qhead, 1u, __ATOMIC_RELAXED, __HIP_MEMORY_SCOPE_AGENT);
            item_done(dcnt);
        }
    }
    SEAM(2);
    if (IN(6)) for (int rep_ = 0; rep_ < REP(6); ++rep_) { pg8::Gemm g{MIX, WoT, M, 1024, 1024}; pg8::StaticOrder S; S.init(M, 1024, G, bid);
        pg8::EpiOut E{x, a.out, HB, rowss};
        pg8::gemm_phase<pg8::EpiOut, pg8::StaticOrder, false, true>(lds, g, S, E); }
    SEAM(6);
    if (IN(7)) for (int rep_ = 0; rep_ < REP(7); ++rep_) { pg8::Gemm g{HB, WguT, M, 2 * DFF, 1024}; pg8::StaticOrder S; S.init(M, 2 * DFF, G, bid);
        pg8::EpiSwiGLU E{HID, rowss};
        pg8::gemm_phase<pg8::EpiSwiGLU, pg8::StaticOrder, true, true>(lds, g, S, E); }
    SEAM(7);
    if (IN(8)) for (int rep_ = 0; rep_ < REP(8); ++rep_) { pg8::Gemm g{HID, WdT, M, 1024, DFF}; pg8::StaticOrder S; S.init(M, 1024, G, bid);
        pg8::EpiDown E{a.out, HB};
        pg8::gemm_phase<pg8::EpiDown, pg8::StaticOrder, false, true>(lds, g, S, E); }
#undef IN
#undef SEAM
}

extern "C" void kernel_launch(void* const* d_in, const int* in_sizes, int n_in, void* d_out, int out_size, void* d_ws, size_t ws_size, hipStream_t stream) {
    static int grid = 0;
    if (grid == 0) {
        if (n_in != 18 || out_size != M * DM || ws_size < WS_END) { fprintf(stderr, "kernel_launch: unexpected shapes (n_in %d, out %d, ws %zu)\n", n_in, out_size, ws_size); grid = -1; return; }
        int dev = 0, cus = 0, per_cu = 0;
        hipGetDevice(&dev); hipDeviceGetAttribute(&cus, hipDeviceAttributeMultiprocessorCount, dev);
        hipFuncSetAttribute((const void*)fwd_megakernel, hipFuncAttributeMaxDynamicSharedMemorySize, LDS_BYTES);
        if (hipOccupancyMaxActiveBlocksPerMultiprocessor(&per_cu, (const void*)fwd_megakernel, NTHR, LDS_BYTES) != hipSuccess || per_cu < 1) per_cu = 1;
        (void)hipGetLastError();
        grid = cus * per_cu;
        if (grid < 1) grid = 256;
    }
    if (grid < 0) return;
    if (hipMemsetAsync((char*)d_ws + WS_BAR, 0, 16384, stream) != hipSuccess) { fprintf(stderr, "kernel_launch: memset failed\n"); return; }
    Args a{};
    for (int i = 0; i < 18; ++i) a.in[i] = (const float*)d_in[i];
    a.out = (float*)d_out; a.ws = (unsigned char*)d_ws;
#if MK_N_LAUNCHES == 1
    a.ph_lo = 0; a.ph_hi = NPHASE;
    void* args[] = {&a};
    hipError_t e = hipLaunchCooperativeKernel((const void*)fwd_megakernel, dim3(grid), dim3(NTHR), args, LDS_BYTES, stream);
    if (e != hipSuccess) fprintf(stderr, "cooperative launch failed: %s (grid %d)\n", hipGetErrorString(e), grid);
#else
    for (int ph = 0; ph < NPHASE; ++ph) { a.ph_lo = ph; a.ph_hi = ph + 1; hipLaunchKernelGGL(fwd_megakernel, dim3(grid), dim3(NTHR), LDS_BYTES, stream, a); }
#endif
}
```

```cpp
#include <hip/hip_runtime.h>
#include <hip/hip_cooperative_groups.h>
#include <cstdio>
#include <cstdint>
namespace cg = cooperative_groups;
#define MK_N_LAUNCHES 1
#define REPEAT_MASK 0

namespace pg8 {
#define PG8_LAS __attribute__((address_space(3)))
typedef unsigned short bf16_t;
typedef short bf16x8 __attribute__((ext_vector_type(8)));
typedef float f32x4 __attribute__((ext_vector_type(4)));
typedef unsigned u32x4 __attribute__((ext_vector_type(4)));
constexpr int BM = 256, BK = 64, HALF = 128, HTB = HALF * BK * 2  , STAGE_BYTES = 8 * HTB, NXCD = 8, WGM = 8;

__host__ __device__ __forceinline__ int lds_byte(int r, int c) { const int st = (r >> 4) * 2 + (c >> 5), rr = r & 15, cc = c & 31, ob = rr * 64 + cc * 2; return st * 1024 + (ob ^ (((ob >> 9) & 1) << 5)); }
__host__ __device__ __forceinline__ void stage_rc(int b, int& R, int& C) { const int st = b / 1024, sb = b % 1024, swz = sb ^ (((sb >> 9) & 1) << 5); R = (st >> 1) * 16 + swz / 64; C = (st & 1) * 32 + (swz % 64) / 2; }
__host__ __device__ __forceinline__ int perm32(int rho) { const int n = rho >> 4, i = rho & 15; return 8 * (i >> 2) + 4 * n + (i & 3); }

struct Unit { int pm, pn; };
struct Gemm { const bf16_t* A; const bf16_t* Bt; int M, N, K; };

struct StaticOrder {
    int nM, nN, nwg, G, c;
    __host__ __device__ void init(int M, int N, int G_, int c_) { nM = M / BM; nN = N / BM; nwg = nM * nN; G = G_; c = c_; }
    __host__ __device__ bool next(int i, Unit& u) const {
        const long L = (long)i * G + c; if (L >= nwg) return false;
        int wgid = (int)L; { const int q = nwg / NXCD, r = nwg % NXCD, xcd = wgid % NXCD, off = wgid / NXCD; wgid = (xcd < r ? xcd * (q + 1) : r * (q + 1) + (xcd - r) * q) + off; }
        const int nig = WGM * nN, gid = wgid / nig, fm = gid * WGM, gsz = (nM - fm) < WGM ? (nM - fm) : WGM;
        u.pm = fm + ((wgid % nig) % gsz); u.pn = (wgid % nig) / gsz; return true;
    }
    __device__ __forceinline__ void a_ready(const Unit&) const {}
    __device__ __forceinline__ void done(const Unit&) const {}
};

__device__ __forceinline__ unsigned cvt_pk_bf16(float lo, float hi) { unsigned r; asm volatile("v_cvt_pk_bf16_f32 %0, %1, %2" : "=v"(r) : "v"(lo), "v"(hi)); return r; }
typedef float f32x2 __attribute__((ext_vector_type(2)));
typedef unsigned u32x2 __attribute__((ext_vector_type(2)));
typedef float f32x2_t __attribute__((ext_vector_type(2))); typedef __bf16 bf16x2_t __attribute__((ext_vector_type(2)));
__device__ __forceinline__ unsigned cvtpk(float lo, float hi) { f32x2_t v = {lo, hi}; bf16x2_t b = __builtin_convertvector(v, bf16x2_t); return __builtin_bit_cast(unsigned, b); }
constexpr float RMS_EPS = 1e-6f;
constexpr float LOG2E = 1.4426950408889634f;
constexpr int PROJ_LD = 3072;

struct EpiInProj {
    static constexpr bool PERM = true, AFTER_DRAIN = false;
    bf16_t* proj; bf16_t* vt; bf16_t* gvt; const float* qg; const float* kg;
    __device__ __forceinline__ void operator()(const f32x4 (&acc)[2][2][4][2], const Unit& u, int wr, int wc, int fr, int fq) const {
        const int pn = u.pn; const int row0 = u.pm * BM + wr * 64 + fr;
        if (pn < 4) {
            const float* g = pn < 2 ? qg : kg; const float sc = pn < 2 ? 0.125f * LOG2E : 1.0f;
            f32x4 gv[2][2];
#pragma unroll
            for (int bj = 0; bj < 2; ++bj)
#pragma unroll
                for (int n = 0; n < 2; ++n) gv[bj][n] = *(const f32x4*)(g + 32 * bj + 8 * fq + 4 * n) * sc;
#pragma unroll
            for (int ai = 0; ai < 2; ++ai)
#pragma unroll
                for (int m = 0; m < 4; ++m) {
                    float ss = 0.f;
#pragma unroll
                    for (int bj = 0; bj < 2; ++bj)
#pragma unroll
                        for (int n = 0; n < 2; ++n) { const f32x4 x = acc[ai][bj][m][n]; ss += (x[0] * x[0] + x[1] * x[1]) + (x[2] * x[2] + x[3] * x[3]); }
                    ss += __shfl_xor(ss, 16); ss += __shfl_xor(ss, 32);
                    const float rstd = rsqrtf(ss * (1.0f / 64.0f) + RMS_EPS);
                    bf16_t* rowp = proj + (size_t)(row0 + ai * HALF + m * 16) * PROJ_LD + pn * 256 + wc * 64 + 8 * fq;
#pragma unroll
                    for (int bj = 0; bj < 2; ++bj) { const f32x4 v0 = acc[ai][bj][m][0] * rstd * gv[bj][0], v1 = acc[ai][bj][m][1] * rstd * gv[bj][1];
                        u32x4 w; w.x = cvtpk(v0[0], v0[1]); w.y = cvtpk(v0[2], v0[3]); w.z = cvtpk(v1[0], v1[1]); w.w = cvtpk(v1[2], v1[3]);
                        *(u32x4*)(rowp + 32 * bj) = w; }
                }
        } else if (pn == 4 || pn == 5 || pn == 8 || pn == 9) {
            bf16_t* dst = pn < 6 ? vt : gvt; const int cb = (pn & 1) * 256 + wc * 64 + 8 * fq;
#pragma unroll
            for (int ai = 0; ai < 2; ++ai)
#pragma unroll
                for (int m = 0; m < 4; ++m) { const int row = row0 + ai * HALF + m * 16; const int b = row >> 13, t = row & 8191;
#pragma unroll
                    for (int bj = 0; bj < 2; ++bj)
#pragma unroll
                        for (int n = 0; n < 2; ++n) { const f32x4 x = acc[ai][bj][m][n]; const int c = cb + 32 * bj + 4 * n; const int h = c >> 7, ev = c & 127;
                            bf16_t* p = dst + ((size_t)((b * 4 + h) * 128 + ev)) * 8192 + t; const unsigned w0 = cvtpk(x[0], x[1]), w1 = cvtpk(x[2], x[3]);
                            p[0] = (bf16_t)(w0 & 0xffffu); p[8192] = (bf16_t)(w0 >> 16); p[2 * 8192] = (bf16_t)(w1 & 0xffffu); p[3 * 8192] = (bf16_t)(w1 >> 16); }
                }
        } else {
            const float sc = pn == 6 ? 0.125f : 1.0f;
#pragma unroll
            for (int ai = 0; ai < 2; ++ai)
#pragma unroll
                for (int m = 0; m < 4; ++m) { bf16_t* rowp = proj + (size_t)(row0 + ai * HALF + m * 16) * PROJ_LD + pn * 256 + wc * 64 + 8 * fq;
#pragma unroll
                    for (int bj = 0; bj < 2; ++bj) { const f32x4 v0 = acc[ai][bj][m][0] * sc, v1 = acc[ai][bj][m][1] * sc;
                        u32x4 w; w.x = cvtpk(v0[0], v0[1]); w.y = cvtpk(v0[2], v0[3]); w.z = cvtpk(v1[0], v1[1]); w.w = cvtpk(v1[2], v1[3]);
                        *(u32x4*)(rowp + 32 * bj) = w; }
                }
        }
    }
};
struct EpiOut {
    static constexpr bool PERM = false, AFTER_DRAIN = false;
    const float* x; float* hout; bf16_t* hb; float* rowss;
    __device__ __forceinline__ void operator()(const f32x4 (&acc)[2][2][4][2], const Unit& u, int wr, int wc, int fr, int fq) const {
        const int row0 = u.pm * BM + wr * 64 + fr, col0 = u.pn * BM + wc * 32 + 4 * fq;
#pragma unroll
        for (int ai = 0; ai < 2; ++ai) {
            f32x4 pre[4][2][2];
#pragma unroll
            for (int m = 0; m < 4; ++m) { const size_t off = (size_t)(row0 + ai * HALF + m * 16) * 1024 + col0;
#pragma unroll
                for (int bj = 0; bj < 2; ++bj)
#pragma unroll
                    for (int n = 0; n < 2; ++n) pre[m][bj][n] = *(const f32x4*)(x + off + bj * HALF + n * 16); }
            asm volatile("" ::: "memory");
#pragma unroll
            for (int m = 0; m < 4; ++m) { const int row = row0 + ai * HALF + m * 16; const size_t off = (size_t)row * 1024 + col0; float ss = 0.f;
#pragma unroll
                for (int bj = 0; bj < 2; ++bj)
#pragma unroll
                    for (int n = 0; n < 2; ++n) { const size_t o2 = off + bj * HALF + n * 16; const f32x4 hv = pre[m][bj][n] + acc[ai][bj][m][n];
                        ss += (hv[0] * hv[0] + hv[1] * hv[1]) + (hv[2] * hv[2] + hv[3] * hv[3]);
                        u32x2 w; w.x = cvtpk(hv[0], hv[1]); w.y = cvtpk(hv[2], hv[3]); *(u32x2*)(hb + o2) = w; }
                ss += __shfl_xor(ss, 16); ss += __shfl_xor(ss, 32);
                if (fq == 0) atomicAdd(rowss + row, ss);
            }
            asm volatile("" ::: "memory");
        }
    }
};
struct EpiSwiGLU {
    static constexpr bool PERM = true, AFTER_DRAIN = false;
    bf16_t* hid; const float* rowss;
    __device__ __forceinline__ void operator()(const f32x4 (&acc)[2][2][4][2], const Unit& u, int wr, int wc, int fr, int fq) const {
        const int row0 = u.pm * BM + wr * 64 + fr, col0 = u.pn * 128 + wc * 32 + 8 * fq;
        float rs[2][4];
#pragma unroll
        for (int ai = 0; ai < 2; ++ai)
#pragma unroll
            for (int m = 0; m < 4; ++m) rs[ai][m] = rowss[row0 + ai * HALF + m * 16];
        asm volatile("" ::: "memory");
#pragma unroll
        for (int ai = 0; ai < 2; ++ai)
#pragma unroll
            for (int m = 0; m < 4; ++m) { const int row = row0 + ai * HALF + m * 16; const float r = rsqrtf(rs[ai][m] * (1.0f / 1024.0f) + RMS_EPS);
                float hv[8];
#pragma unroll
                for (int n = 0; n < 2; ++n)
#pragma unroll
                    for (int e = 0; e < 4; ++e) { const float g = acc[ai][0][m][n][e] * r, uu = acc[ai][1][m][n][e] * r;
                        hv[4 * n + e] = g * __builtin_amdgcn_rcpf(1.0f + __builtin_amdgcn_exp2f(-g * LOG2E)) * uu; }
                u32x4 w; w.x = cvtpk(hv[0], hv[1]); w.y = cvtpk(hv[2], hv[3]); w.z = cvtpk(hv[4], hv[5]); w.w = cvtpk(hv[6], hv[7]);
                *(u32x4*)(hid + (size_t)row * 2816 + col0) = w; }
    }
};
struct EpiDown {
    static constexpr bool PERM = false, AFTER_DRAIN = false;
    float* out; const bf16_t* hb;
    __device__ __forceinline__ void operator()(const f32x4 (&acc)[2][2][4][2], const Unit& u, int wr, int wc, int fr, int fq) const {
        const int row0 = u.pm * BM + wr * 64 + fr, col0 = u.pn * BM + wc * 32 + 4 * fq;
#pragma unroll
        for (int ai = 0; ai < 2; ++ai) {
            u32x2 pre[4][2][2];
#pragma unroll
            for (int m = 0; m < 4; ++m) { const size_t off = (size_t)(row0 + ai * HALF + m * 16) * 1024 + col0;
#pragma unroll
                for (int bj = 0; bj < 2; ++bj)
#pragma unroll
                    for (int n = 0; n < 2; ++n) pre[m][bj][n] = *(const u32x2*)(hb + off + bj * HALF + n * 16); }
            asm volatile("" ::: "memory");
#pragma unroll
            for (int m = 0; m < 4; ++m) { const size_t off = (size_t)(row0 + ai * HALF + m * 16) * 1024 + col0;
#pragma unroll
                for (int bj = 0; bj < 2; ++bj)
#pragma unroll
                    for (int n = 0; n < 2; ++n) { const u32x2 hw = pre[m][bj][n];
                        const f32x4 hv = {__uint_as_float(hw.x << 16), __uint_as_float(hw.x & 0xffff0000u), __uint_as_float(hw.y << 16), __uint_as_float(hw.y & 0xffff0000u)};
                        *(f32x4*)(out + off + bj * HALF + n * 16) = hv + acc[ai][bj][m][n]; } }
            asm volatile("" ::: "memory");
        }
    }
};
template <class Epi, class Sched, bool ALIGN_EPI = false, bool SP2 = false>
__device__ __forceinline__ void gemm_phase(PG8_LAS unsigned char* lds, const Gemm g, const Sched& S, const Epi& E) {
    int tid_ = threadIdx.x; asm volatile("" : "+v"(tid_)); const int tid = tid_, wid = __builtin_amdgcn_readfirstlane(tid >> 6), lane = tid & 63, wr = wid >> 2, wc = wid & 3, fr = lane & 15, fq = lane >> 4;
    const int K = g.K, nt = K / BK;
    unsigned voffA[2], voffB[2];
#pragma unroll
    for (int i = 0; i < 2; ++i) { int R, C; stage_rc(tid * 16 + i * 8192, R, C); const int Rb = Epi::PERM ? ((R & ~31) + perm32(R & 31)) : R;
        voffA[i] = (unsigned)(R * K + C) * 2u; voffB[i] = (unsigned)(Rb * K + C) * 2u; }
    const size_t kstep = (size_t)(BK * 2);
    const size_t hstep = (size_t)HALF * K * 2;
    const size_t tstep = 2 * hstep;
    const unsigned ldsw = (unsigned)wid * 1024u;
    const int aoff = lds_byte(wr * 64 + fr, fq * 8), boff = lds_byte(wc * 32 + fr, fq * 8);
#define PG8_SA(b, h) (((b) * 2 + (h)) * HTB)
#define PG8_SB(b, h) ((4 + (b) * 2 + (h)) * HTB)
#define PG8_STAGE(bufoff, gbase, voff) do { _Pragma("unroll") for (int _i = 0; _i < 2; ++_i) \
        __builtin_amdgcn_global_load_lds((const unsigned*)((const char*)(gbase) + (voff)[_i]), (PG8_LAS unsigned*)(lds + (bufoff) + ldsw + _i * 8192), 16, 0, 0); } while (0)
#define PG8_LDA(dst, b, h) do { _Pragma("unroll") for (int m = 0; m < 4; ++m) _Pragma("unroll") for (int k = 0; k < 2; ++k) dst[m][k] = *(const PG8_LAS bf16x8*)(lds + PG8_SA(b, h) + aoff + m * 2048 + k * 1024); } while (0)
#define PG8_LDB(dst, b, h) do { _Pragma("unroll") for (int n = 0; n < 2; ++n) _Pragma("unroll") for (int k = 0; k < 2; ++k) dst[n][k] = *(const PG8_LAS bf16x8*)(lds + PG8_SB(b, h) + boff + n * 2048 + k * 1024); } while (0)
#define PG8_MMA(ai, bj, At, Bt) do { __builtin_amdgcn_s_setprio(1); _Pragma("unroll") for (int m = 0; m < 4; ++m) _Pragma("unroll") for (int n = 0; n < 2; ++n) _Pragma("unroll") for (int k = 0; k < 2; ++k) \
        acc[ai][bj][m][n] = __builtin_amdgcn_mfma_f32_16x16x32_bf16(Bt[n][k], At[m][k], acc[ai][bj][m][n], 0, 0, 0); __builtin_amdgcn_s_setprio(0); } while (0)
#define PG8_WAIT_V(n) asm volatile("s_waitcnt vmcnt(" #n ")" ::: "memory")
#define PG8_WAIT_L(n) asm volatile("s_waitcnt lgkmcnt(" #n ")" ::: "memory")
#define PG8_BAR __builtin_amdgcn_s_barrier()
#define PG8_SCHED __builtin_amdgcn_sched_barrier(0)
    Unit cur, nxt; int ui = 0;
    if (!S.next(0, cur)) return;
    f32x4 acc[2][2][4][2];
#pragma unroll
    for (int a = 0; a < 2; ++a)
#pragma unroll
        for (int b = 0; b < 2; ++b)
#pragma unroll
            for (int m = 0; m < 4; ++m)
#pragma unroll
                for (int n = 0; n < 2; ++n) acc[a][b][m][n] = (f32x4){0.f, 0.f, 0.f, 0.f};
    bf16x8 At[4][2], B0[2][2], B1[2][2];
    const char* cA = (const char*)g.A + (size_t)cur.pm * tstep; const char* cB = (const char*)g.Bt + (size_t)cur.pn * tstep;
    S.a_ready(cur);
    if constexpr (SP2) {
        PG8_STAGE(PG8_SB(0, 0), cB, voffB); PG8_STAGE(PG8_SB(0, 1), cB + hstep, voffB); PG8_STAGE(PG8_SA(0, 0), cA, voffA); PG8_STAGE(PG8_SA(0, 1), cA + hstep, voffA);
        if (wr == 1) PG8_BAR;
        PG8_WAIT_V(2); PG8_BAR;
        PG8_STAGE(PG8_SB(1, 0), cB + kstep, voffB); PG8_STAGE(PG8_SA(1, 0), cA + kstep, voffA); PG8_STAGE(PG8_SB(1, 1), cB + hstep + kstep, voffB);
        PG8_WAIT_V(6); PG8_BAR;
    } else {
        PG8_STAGE(PG8_SB(0, 0), cB, voffB); PG8_STAGE(PG8_SA(0, 0), cA, voffA); PG8_STAGE(PG8_SB(0, 1), cB + hstep, voffB); PG8_STAGE(PG8_SA(0, 1), cA + hstep, voffA);
        if (wr == 1) PG8_BAR;
        PG8_WAIT_V(4); PG8_BAR;
        PG8_STAGE(PG8_SB(1, 0), cB + kstep, voffB); PG8_STAGE(PG8_SA(1, 0), cA + kstep, voffA); PG8_STAGE(PG8_SB(1, 1), cB + hstep + kstep, voffB);
        PG8_WAIT_V(6); PG8_BAR;
    }
    for (;;) {
        const bool has_next = S.next(ui + 1, nxt);
        const char* nA = has_next ? (const char*)g.A + (size_t)nxt.pm * tstep : cA; const char* nB = has_next ? (const char*)g.Bt + (size_t)nxt.pn * tstep : cB;
        for (int t = 0; t < nt; t += 2) {
            const bool last = (t == nt - 2);
            const char* a1 = cA + (size_t)(t + 1) * kstep;
            const char* a2 = last ? nA : cA + (size_t)(t + 2) * kstep; const char* b2 = last ? nB : cB + (size_t)(t + 2) * kstep;
            const char* a3 = a2 + kstep; const char* b3 = b2 + kstep;
            if (last && has_next) S.a_ready(nxt);
            if constexpr (SP2) {
            PG8_LDB(B0, 0, 0); PG8_LDB(B1, 0, 1); PG8_SCHED; PG8_LDA(At, 0, 0); PG8_STAGE(PG8_SA(1, 1), a1 + hstep, voffA);
            PG8_WAIT_V(8); PG8_WAIT_L(0); PG8_BAR; PG8_MMA(0, 0, At, B0); PG8_MMA(0, 1, At, B1); PG8_BAR; PG8_SCHED;
            PG8_LDA(At, 0, 1); PG8_STAGE(PG8_SB(0, 0), b2, voffB); PG8_STAGE(PG8_SB(0, 1), b2 + hstep, voffB); PG8_STAGE(PG8_SA(0, 0), a2, voffA);
            PG8_WAIT_V(8); PG8_WAIT_L(0); PG8_BAR; PG8_MMA(1, 0, At, B0); PG8_MMA(1, 1, At, B1); PG8_BAR; PG8_SCHED;
            PG8_LDB(B0, 1, 0); PG8_LDB(B1, 1, 1); PG8_SCHED; PG8_LDA(At, 1, 0); PG8_STAGE(PG8_SA(0, 1), a2 + hstep, voffA);
            PG8_WAIT_V(8); PG8_WAIT_L(0); PG8_BAR; PG8_MMA(0, 0, At, B0); PG8_MMA(0, 1, At, B1); PG8_BAR; PG8_SCHED;
            PG8_LDA(At, 1, 1); PG8_STAGE(PG8_SB(1, 0), b3, voffB); PG8_STAGE(PG8_SB(1, 1), b3 + hstep, voffB); PG8_STAGE(PG8_SA(1, 0), a3, voffA);
            PG8_WAIT_V(8); PG8_WAIT_L(0); PG8_BAR; PG8_MMA(1, 0, At, B0); PG8_MMA(1, 1, At, B1); PG8_BAR; PG8_SCHED;
            } else {
            PG8_LDB(B0, 0, 0); PG8_SCHED; PG8_LDA(At, 0, 0); PG8_STAGE(PG8_SA(1, 1), a1 + hstep, voffA);
            PG8_WAIT_L(8); PG8_BAR; PG8_WAIT_L(0); PG8_MMA(0, 0, At, B0); PG8_BAR; PG8_SCHED;
            PG8_LDB(B1, 0, 1); PG8_STAGE(PG8_SB(0, 0), b2, voffB);
            PG8_BAR; PG8_WAIT_L(0); PG8_MMA(0, 1, At, B1); PG8_BAR;
            PG8_LDA(At, 0, 1); PG8_STAGE(PG8_SA(0, 0), a2, voffA);
            PG8_BAR; PG8_WAIT_L(0); PG8_MMA(1, 0, At, B0); PG8_BAR; PG8_SCHED;
            PG8_STAGE(PG8_SB(0, 1), b2 + hstep, voffB);
            PG8_WAIT_V(6); PG8_BAR; PG8_MMA(1, 1, At, B1); PG8_BAR;
            PG8_LDB(B0, 1, 0); PG8_SCHED; PG8_LDA(At, 1, 0); PG8_STAGE(PG8_SA(0, 1), a2 + hstep, voffA);
            PG8_WAIT_L(8); PG8_BAR; PG8_WAIT_L(0); PG8_MMA(0, 0, At, B0); PG8_BAR; PG8_SCHED;
            PG8_LDB(B1, 1, 1); PG8_STAGE(PG8_SB(1, 0), b3, voffB);
            PG8_BAR; PG8_WAIT_L(0); PG8_MMA(0, 1, At, B1); PG8_BAR;
            PG8_LDA(At, 1, 1); PG8_STAGE(PG8_SA(1, 0), a3, voffA);
            PG8_BAR; PG8_WAIT_L(0); PG8_MMA(1, 0, At, B0); PG8_BAR; PG8_SCHED;
            PG8_STAGE(PG8_SB(1, 1), b3 + hstep, voffB);
            PG8_WAIT_V(6); PG8_BAR; PG8_MMA(1, 1, At, B1); PG8_BAR;
            }
        }
        if constexpr (ALIGN_EPI) { if (wr == 0) PG8_BAR; }
        if constexpr (!Epi::AFTER_DRAIN) { E(acc, cur, wr, wc, fr, fq); S.done(cur); }
        if (!has_next) break;
#pragma unroll
        for (int a = 0; a < 2; ++a)
#pragma unroll
            for (int b = 0; b < 2; ++b)
#pragma unroll
                for (int m = 0; m < 4; ++m)
#pragma unroll
                    for (int n = 0; n < 2; ++n) acc[a][b][m][n] = (f32x4){0.f, 0.f, 0.f, 0.f};
        cur = nxt; cA = nA; cB = nB; ++ui;
        if constexpr (ALIGN_EPI) { if (wr == 1) PG8_BAR; }
    }
    PG8_WAIT_V(0);
    if constexpr (!ALIGN_EPI) { if (wr == 0) PG8_BAR; }
    PG8_BAR;
    if constexpr (Epi::AFTER_DRAIN) { E.fused(acc, cur, wr, wc, fr, fq, lds, wid, lane); S.done(cur); }
#undef PG8_SA
#undef PG8_SB
#undef PG8_STAGE
#undef PG8_LDA
#undef PG8_LDB
#undef PG8_MMA
#undef PG8_WAIT_V
#undef PG8_WAIT_L
#undef PG8_BAR
#undef PG8_SCHED
}
}
using pg8::bf16_t; using pg8::bf16x8; using pg8::f32x4; using pg8::u32x4; using pg8::u32x2; using pg8::cvtpk; using pg8::RMS_EPS; using pg8::LOG2E;
typedef float f32x16 __attribute__((ext_vector_type(16)));
#define LAS __attribute__((address_space(3)))
constexpr int NTHR = 512, NWAVES = 8;
constexpr int BATCH = 2, SEQ = 8192, DM = 1024, M = BATCH * SEQ, DFF = 2816, INW = 3088;
constexpr size_t MiB = 1u << 20;
constexpr size_t WS_BAR = 0;
constexpr size_t WS_QHEAD = 15360;
constexpr size_t WS_ROWSS = 64 * 1024;
constexpr size_t WS_WIN = 2 * MiB;
constexpr size_t WS_WO = 8 * MiB;
constexpr size_t WS_WGU = 10 * MiB;
constexpr size_t WS_WD = 21 * MiB;
constexpr size_t WS_GLR = 27 * MiB;
constexpr size_t WS_DVEC = 28 * MiB;
constexpr size_t WS_XN = 32 * MiB;
constexpr size_t WS_PROJ = 64 * MiB;
constexpr size_t WS_VT = 160 * MiB;
constexpr size_t WS_GVT = 176 * MiB;
constexpr size_t WS_MIX = 192 * MiB;
constexpr size_t WS_ST = 224 * MiB;
constexpr size_t WS_END = 256 * MiB;
constexpr int LDS_BYTES = 147456;

__device__ __forceinline__ float bf2f(bf16_t v) { return __uint_as_float((unsigned)v << 16); }
__device__ __forceinline__ bf16_t f2bf(float f) { return (bf16_t)(cvtpk(f, f) & 0xffffu); }
__device__ __forceinline__ float wave_sum(float v) {
#pragma unroll
    for (int o = 1; o < 64; o <<= 1) v += __shfl_xor(v, o);
    return v;
}
__device__ __forceinline__ float wave_max(float v) {
#pragma unroll
    for (int o = 1; o < 64; o <<= 1) v = fmaxf(v, __shfl_xor(v, o));
    return v;
}
__device__ __forceinline__ int crow(int r, int hi) { return (r & 3) + 8 * (r >> 2) + 4 * hi; }
__device__ __forceinline__ int pi_row(int m) { return (m & ~12) | ((m & 4) << 1) | ((m & 8) >> 1); }
__device__ __forceinline__ bf16x8 pack8(float a0, float a1, float a2, float a3, float a4, float a5, float a6, float a7) {
    u32x4 w; w.x = cvtpk(a0, a1); w.y = cvtpk(a2, a3); w.z = cvtpk(a4, a5); w.w = cvtpk(a6, a7); return __builtin_bit_cast(bf16x8, w);
}

template <int MODE> __device__ __forceinline__ int wrow(int n) {
    if (MODE == 1) { const int pn = n >> 8, L = n & 255; return pn * 256 + ((L >> 5) & 1) * 128 + (L >> 6) * 32 + (L & 31); }
    if (MODE == 2) return (n >> 7) * 256 + (n & 127);
    if (MODE == 3) return (n >> 7) * 256 + 128 + (n & 127);
    return n;
}
template <int MODE> __device__ __forceinline__ void p0_transpose_item(const float* W, int ld, int K, int ncols, bf16_t* WT, const float* gain, LAS float* scr, int item, int lane) {
    const int nblk = ncols / 32, kb = item / nblk, nb = item % nblk, k0 = 64 * kb, n0 = 32 * nb;
    float tv[32];
#pragma unroll
    for (int i = 0; i < 32; ++i) { const int kk = 2 * i + (lane >> 5); tv[i] = W[(size_t)(k0 + kk) * ld + n0 + (lane & 31)]; }
    if (gain) {
#pragma unroll
        for (int i = 0; i < 32; ++i) tv[i] *= gain[k0 + 2 * i + (lane >> 5)];
    }
#pragma unroll
    for (int i = 0; i < 32; ++i) scr[(2 * i + (lane >> 5)) * 33 + (lane & 31)] = tv[i];
    asm volatile("s_waitcnt lgkmcnt(0)" ::: "memory");
    const int c = lane & 7;
#pragma unroll
    for (int j = 0; j < 4; ++j) { const int n = (lane >> 3) + 8 * j; const LAS float* s = scr + (8 * c) * 33 + n;
        u32x4 o; o.x = cvtpk(s[0 * 33], s[1 * 33]); o.y = cvtpk(s[2 * 33], s[3 * 33]); o.z = cvtpk(s[4 * 33], s[5 * 33]); o.w = cvtpk(s[6 * 33], s[7 * 33]);
        *(u32x4*)(WT + (size_t)wrow<MODE>(n0 + n) * K + k0 + 8 * c) = o; }
    asm volatile("s_waitcnt lgkmcnt(0)" ::: "memory");
}
struct P0Args { const float *x, *again, *w_in, *w_out, *fgain, *w_g, *w_u, *w_d; bf16_t *WinT, *WoT, *WguT, *WdT, *XN; float *glr, *rowss; };
__device__ __forceinline__ void p0_prologue(LAS unsigned char* lds, const P0Args& A, int G, int bid) {
    int tid_ = threadIdx.x; asm volatile("" : "+v"(tid_)); const int tid = tid_, lane = tid & 63, wave = __builtin_amdgcn_readfirstlane(tid >> 6);
    LAS float* scr = (LAS float*)(lds + wave * 16384);
    const int gw = bid * NWAVES + wave, NGW = G * NWAVES;
    for (int i = bid * NTHR + tid; i < M; i += G * NTHR) A.rowss[i] = 0.f;
    for (int it = gw; it < 16 * 96; it += NGW) p0_transpose_item<1>(A.w_in, INW, 1024, 3072, A.WinT, nullptr, scr, it, lane);
    __syncthreads();
    LAS float* WtT = (LAS float*)lds;
    { float wv[32];
#pragma unroll
      for (int q = 0; q < 32; ++q) { const int i = tid + NTHR * q; wv[q] = A.w_in[(size_t)(i >> 4) * INW + 3072 + (i & 15)]; }
#pragma unroll
      for (int q = 0; q < 32; ++q) { const int i = tid + NTHR * q; WtT[(i & 15) * 1024 + (i >> 4)] = wv[q]; } }
    __syncthreads();
    f32x4 gnv[4];
#pragma unroll
    for (int j = 0; j < 4; ++j) gnv[j] = ((const f32x4*)A.again)[64 * j + lane];
    for (int m = gw; m < M; m += NGW) {
        const f32x4* xr = (const f32x4*)(A.x + (size_t)m * 1024) + lane;
        f32x4 v[4]; float ss = 0.f;
#pragma unroll
        for (int j = 0; j < 4; ++j) { v[j] = xr[64 * j]; ss += (v[j][0] * v[j][0] + v[j][1] * v[j][1]) + (v[j][2] * v[j][2] + v[j][3] * v[j][3]); }
        const float rstd = rsqrtf(wave_sum(ss) * (1.0f / 1024.0f) + RMS_EPS);
        unsigned long long* o8 = (unsigned long long*)(A.XN + (size_t)m * 1024) + lane;
#pragma unroll
        for (int j = 0; j < 4; ++j) { const f32x4 g = gnv[j]; v[j] = v[j] * rstd * g;
            o8[64 * j] = (unsigned long long)cvtpk(v[j][0], v[j][1]) | ((unsigned long long)cvtpk(v[j][2], v[j][3]) << 32); }
        float p[16];
#pragma unroll
        for (int r = 0; r < 16; ++r) { float a = 0.f;
#pragma unroll
            for (int j = 0; j < 4; ++j) { const f32x4 w = *(const LAS f32x4*)(WtT + r * 1024 + 256 * j + 4 * lane); a += (v[j][0] * w[0] + v[j][1] * w[1]) + (v[j][2] * w[2] + v[j][3] * w[3]); }
            p[r] = a; if (r & 1) asm volatile("" ::: "memory"); }
#pragma unroll
        for (int i = 0; i < 8; ++i) { const bool up = lane & 1; const float send = up ? p[i] : p[i + 8], keep = up ? p[i + 8] : p[i]; p[i] = keep + __shfl_xor(send, 1); }
#pragma unroll
        for (int i = 0; i < 4; ++i) { const bool up = lane & 2; const float send = up ? p[i] : p[i + 4], keep = up ? p[i + 4] : p[i]; p[i] = keep + __shfl_xor(send, 2); }
#pragma unroll
        for (int i = 0; i < 2; ++i) { const bool up = lane & 4; const float send = up ? p[i] : p[i + 2], keep = up ? p[i + 2] : p[i]; p[i] = keep + __shfl_xor(send, 4); }
        { const bool up = lane & 8; const float send = up ? p[0] : p[1], keep = up ? p[1] : p[0]; p[0] = keep + __shfl_xor(send, 8); }
        p[0] += __shfl_xor(p[0], 16); p[0] += __shfl_xor(p[0], 32);
        if (lane < 16) { const int r = 8 * (lane & 1) + 4 * ((lane >> 1) & 1) + 2 * ((lane >> 2) & 1) + ((lane >> 3) & 1); A.glr[(size_t)m * 16 + r] = p[0]; }
    }
}

constexpr int LW_O = 16 * 32, LW_G = 16 * 88, LW_D = 44 * 32, LW_ITEMS = LW_O + 2 * LW_G + LW_D, LW_BLOCK_ITEMS = LW_ITEMS / 8;
static_assert(LW_ITEMS % 8 == 0, "late-weight pieces come in groups of eight");
__device__ __forceinline__ void late_weights_item(LAS unsigned char* lds, const P0Args& A, int bi) {
    int tid_ = threadIdx.x; asm volatile("" : "+v"(tid_)); const int lane = tid_ & 63, wave = __builtin_amdgcn_readfirstlane(tid_ >> 6);
    LAS float* scr = (LAS float*)(lds + wave * 16384);
    int r = bi * 8 + wave;
    if (r < LW_O) { p0_transpose_item<0>(A.w_out, 1024, 1024, 1024, A.WoT, nullptr, scr, r, lane); return; } r -= LW_O;
    if (r < LW_G) { p0_transpose_item<2>(A.w_g, DFF, 1024, DFF, A.WguT, A.fgain, scr, r, lane); return; } r -= LW_G;
    if (r < LW_G) { p0_transpose_item<3>(A.w_u, DFF, 1024, DFF, A.WguT, A.fgain, scr, r, lane); return; } r -= LW_G;
    p0_transpose_item<0>(A.w_d, 1024, DFF, 1024, A.WdT, nullptr, scr, r, lane);
}
constexpr int RS = 144;
constexpr int G1_GLR = 0, G1_TOT = 4096, G1_QT = 6144, G1_KT = G1_QT + 64 * RS, G1_KD = G1_KT + 64 * RS, G1_VT = G1_KD + 64 * RS;
struct GlaArgs { const bf16_t* proj; const bf16_t* gvt; const float* glr; const float* w_up; const float* b_gate; bf16_t* QT; float* OINTRA; float* ST; float* dvec; };
__device__ __forceinline__ void gla_chunk_load(const GlaArgs& A, int task, int tid, int lane, int wid, float (&g)[2], u32x4 (&v)[2], unsigned (&qv)[8], unsigned (&kv)[8]) {
    const int bh = task >> 7, c = task & 127, b = bh >> 2, h = bh & 3; const int tok0 = b * SEQ + c * 64;
#pragma unroll
    for (int i = 0; i < 2; ++i) g[i] = A.glr[(size_t)tok0 * 16 + tid + NTHR * i];
#pragma unroll
    for (int i = 0; i < 2; ++i) { const int idx = tid + NTHR * i, row = idx >> 3, ch = idx & 7; v[i] = *(const u32x4*)(A.gvt + ((size_t)(bh * 128 + row)) * SEQ + c * 64 + ch * 8); }
#pragma unroll
    for (int i = 0; i < 8; ++i) { const bf16_t* p = A.proj + (size_t)(tok0 + 8 * wid + i) * 3072 + 1536 + h * 64 + lane; qv[i] = (unsigned)p[0]; kv[i] = (unsigned)p[256]; }
}
__device__ __forceinline__ void gla_chunk_body(LAS unsigned char* lds, const GlaArgs& A, int task, int tid, int lane, int wid, const float (&g)[2], const u32x4 (&v)[2], const unsigned (&qr)[8], const unsigned (&kr)[8], const float (&wup)[16], float bias) {
    const int r32 = lane & 31, hi = lane >> 5;
    LAS float* glrS = (LAS float*)(lds + G1_GLR); LAS float* tot = (LAS float*)(lds + G1_TOT);
    {
#pragma unroll
        for (int i = 0; i < 2; ++i) glrS[tid + NTHR * i] = g[i];
#pragma unroll
        for (int i = 0; i < 2; ++i) { const int idx = tid + NTHR * i, row = idx >> 3, ch = idx & 7; *(LAS u32x4*)(lds + G1_VT + row * RS + ch * 16) = v[i]; }
        __syncthreads();
        float cum[8]; float run = 0.f;
#pragma unroll
        for (int i = 0; i < 8; ++i) { const int t = 8 * wid + i; float z = bias;
#pragma unroll
            for (int r = 0; r < 16; ++r) z += glrS[t * 16 + r] * wup[r];
            const float y = -z; const float sp = fmaxf(y, 0.f) + log1pf(__expf(-fabsf(y)));
            run -= sp * (1.0f / 16.0f); cum[i] = run; }
        tot[wid * 64 + lane] = run;
        __syncthreads();
        float prefix = 0.f, total = 0.f;
#pragma unroll
        for (int w = 0; w < 8; ++w) { const float tv = tot[w * 64 + lane]; total += tv; if (w < wid) prefix += tv; }
        float kd[8];
#pragma unroll
        for (int i = 0; i < 8; ++i) { const int t = 8 * wid + i; const float bb = prefix + cum[i]; const float qvi = __uint_as_float(qr[i] << 16), kvi = __uint_as_float(kr[i] << 16);
            const bf16_t qt = f2bf(qvi * __expf(bb)), kt = f2bf(kvi * __expf(-bb)); kd[i] = kvi * __expf(total - bb);
            *(LAS bf16_t*)(lds + G1_QT + t * RS + lane * 2) = qt; *(LAS bf16_t*)(lds + G1_KT + t * RS + lane * 2) = kt;
            A.QT[(size_t)task * 4096 + t * 64 + lane] = qt; }
        *(LAS bf16x8*)(lds + G1_KD + lane * RS + wid * 16) = pack8(kd[0], kd[1], kd[2], kd[3], kd[4], kd[5], kd[6], kd[7]);
        if (wid == 0) A.dvec[task * 64 + lane] = __expf(total);
        __syncthreads();
        const int tb = wid & 1, vb = wid >> 1;
        f32x16 o = {};
#pragma unroll
        for (int sb = 0; sb < 2; ++sb) {
            if (sb <= tb) {
                f32x16 X = {};
#pragma unroll
                for (int ks = 0; ks < 4; ++ks) {
                    const bf16x8 a = *(const LAS bf16x8*)(lds + G1_KT + (32 * sb + pi_row(r32)) * RS + (16 * ks + 8 * hi) * 2);
                    const bf16x8 bq = *(const LAS bf16x8*)(lds + G1_QT + (32 * tb + r32) * RS + (16 * ks + 8 * hi) * 2);
                    X = __builtin_amdgcn_mfma_f32_32x32x16_bf16(a, bq, X, 0, 0, 0);
                }
                if (sb == tb) {
#pragma unroll
                    for (int r = 0; r < 16; ++r) { if ((16 * (r >> 3) + (r & 7)) > r32 - 8 * hi) X[r] = 0.f; }
                }
                const bf16x8 P0 = pack8(X[0], X[1], X[2], X[3], X[4], X[5], X[6], X[7]), P1 = pack8(X[8], X[9], X[10], X[11], X[12], X[13], X[14], X[15]);
                const bf16x8 v0 = *(const LAS bf16x8*)(lds + G1_VT + (32 * vb + r32) * RS + (32 * sb + 8 * hi) * 2);
                const bf16x8 v1 = *(const LAS bf16x8*)(lds + G1_VT + (32 * vb + r32) * RS + (32 * sb + 16 + 8 * hi) * 2);
                o = __builtin_amdgcn_mfma_f32_32x32x16_bf16(P0, v0, o, 0, 0, 0);
                o = __builtin_amdgcn_mfma_f32_32x32x16_bf16(P1, v1, o, 0, 0, 0);
            }
        }
        u32x4* op = (u32x4*)((unsigned*)A.OINTRA + (size_t)task * 4096 + (tb * 4 + vb) * 512 + lane * 8);
#pragma unroll
        for (int q4 = 0; q4 < 2; ++q4) { u32x4 w; w.x = cvtpk(o[8 * q4], o[8 * q4 + 1]); w.y = cvtpk(o[8 * q4 + 2], o[8 * q4 + 3]); w.z = cvtpk(o[8 * q4 + 4], o[8 * q4 + 5]); w.w = cvtpk(o[8 * q4 + 6], o[8 * q4 + 7]); op[q4] = w; }
        f32x16 ut = {};
#pragma unroll
        for (int ks = 0; ks < 4; ++ks) {
            const bf16x8 a = *(const LAS bf16x8*)(lds + G1_VT + (32 * vb + r32) * RS + (16 * ks + 8 * hi) * 2);
            const bf16x8 bk = *(const LAS bf16x8*)(lds + G1_KD + (32 * tb + r32) * RS + (16 * ks + 8 * hi) * 2);
            ut = __builtin_amdgcn_mfma_f32_32x32x16_bf16(a, bk, ut, 0, 0, 0);
        }
        float* sp = A.ST + (size_t)task * 8192 + 32 * tb + r32;
#pragma unroll
        for (int r = 0; r < 16; ++r) sp[(32 * vb + crow(r, hi)) * 64] = ut[r];
        __syncthreads();
    }
}
__device__ __forceinline__ void gla_chunk_quad(LAS unsigned char* lds, const GlaArgs& A, int task0) {
    int tid_ = threadIdx.x; asm volatile("" : "+v"(tid_)); const int tid = tid_, lane = tid & 63, wid = __builtin_amdgcn_readfirstlane(tid >> 6);
    const int h = (task0 >> 7) & 3;
    float gA[2], gB[2], gC[2], gD[2]; u32x4 vA[2], vB[2], vC[2], vD[2]; unsigned qA[8], kA[8], qB[8], kB[8], qC[8], kC[8], qD[8], kD[8];
    gla_chunk_load(A, task0, tid, lane, wid, gA, vA, qA, kA);
    gla_chunk_load(A, task0 + 1, tid, lane, wid, gB, vB, qB, kB);
    gla_chunk_load(A, task0 + 2, tid, lane, wid, gC, vC, qC, kC);
    gla_chunk_load(A, task0 + 3, tid, lane, wid, gD, vD, qD, kD);
    float wup[16];
#pragma unroll
    for (int r = 0; r < 16; ++r) wup[r] = A.w_up[r * 256 + h * 64 + lane];
    const float bias = A.b_gate[h * 64 + lane];
    gla_chunk_body(lds, A, task0, tid, lane, wid, gA, vA, qA, kA, wup, bias);
    gla_chunk_body(lds, A, task0 + 1, tid, lane, wid, gB, vB, qB, kB, wup, bias);
    gla_chunk_body(lds, A, task0 + 2, tid, lane, wid, gC, vC, qC, kC, wup, bias);
    gla_chunk_body(lds, A, task0 + 3, tid, lane, wid, gD, vD, qD, kD, wup, bias);
}
__device__ __forceinline__ void gla_scan_phase(float* ST, const float* dvec, int G, int bid) {
    int tid_ = threadIdx.x; asm volatile("" : "+v"(tid_));
    for (int gid = bid * NTHR + tid_; gid < 65536; gid += G * NTHR) {
        const int bh = gid >> 13, e = gid & 8191, k = e & 63;
        float* sp = ST + (size_t)bh * 128 * 8192 + e; const float* dp = dvec + bh * 128 * 64 + k;
        float S = 0.f;
        for (int c0 = 0; c0 < 128; c0 += 32) {
            float u[32], d[32];
#pragma unroll
            for (int j = 0; j < 32; ++j) { u[j] = sp[(size_t)(c0 + j) * 8192]; d[j] = dp[(c0 + j) * 64]; }
#pragma unroll
            for (int j = 0; j < 32; ++j) { sp[(size_t)(c0 + j) * 8192] = S; S = d[j] * S + u[j]; }
        }
    }
}
__device__ __forceinline__ void gla_scan_item(float* ST, const float* dvec, int j) {
    int tid_ = threadIdx.x; asm volatile("" : "+v"(tid_));
    {
        const int bh = j >> 4, e = (j & 15) * NTHR + tid_, k = e & 63;
        float* sp = ST + (size_t)bh * 128 * 8192 + e; const float* dp = dvec + bh * 128 * 64 + k;
        float S = 0.f;
        for (int c0 = 0; c0 < 128; c0 += 8) {
            float u[8], d[8];
#pragma unroll
            for (int jj = 0; jj < 8; ++jj) { u[jj] = sp[(size_t)(c0 + jj) * 8192]; d[jj] = dp[(c0 + jj) * 64]; }
#pragma unroll
            for (int jj = 0; jj < 8; ++jj) { sp[(size_t)(c0 + jj) * 8192] = S; S = d[jj] * S + u[jj]; }
        }
    }
}
__device__ __forceinline__ void item_done(unsigned* cnt) {
    if (cnt != nullptr) asm volatile("s_waitcnt vmcnt(0)" ::: "memory");
    __builtin_amdgcn_s_barrier();
    if (threadIdx.x == 0 && cnt != nullptr) { __builtin_amdgcn_fence(__ATOMIC_RELEASE, "agent"); asm volatile("s_waitcnt vmcnt(0)" ::: "memory"); __hip_atomic_fetch_add(cnt, 1u, __ATOMIC_RELAXED, __HIP_MEMORY_SCOPE_AGENT); }
}
__device__ __forceinline__ void item_wait(unsigned* cnt, unsigned want) {
    if (threadIdx.x == 0 && cnt != nullptr) { unsigned spn = 0; while (__hip_atomic_load(cnt, __ATOMIC_RELAXED, __HIP_MEMORY_SCOPE_AGENT) < want) { __builtin_amdgcn_s_sleep(2); if (++spn > (1u << 16)) break; }
        __builtin_amdgcn_fence(__ATOMIC_ACQUIRE, "agent"); asm volatile("s_waitcnt vmcnt(0)" ::: "memory"); }
    __syncthreads();
}
struct Gla3Args { const bf16_t* proj; const bf16_t* QT; const float* OINTRA; const float* ST; const float* ggain; bf16_t* mixed; };
__device__ __forceinline__ void gla_out_task(const Gla3Args& A, int wt) {
    int tid_ = threadIdx.x; asm volatile("" : "+v"(tid_)); const int tid = tid_, lane = tid & 63, r32 = lane & 31, hi = lane >> 5;
    {
        const int task = wt >> 1, tb = wt & 1, bh = task >> 7, c = task & 127, b = bh >> 2, h = bh & 3; const int tok0 = b * SEQ + c * 64 + 32 * tb;
        const bf16_t* grow = A.proj + (size_t)tok0 * 3072 + 2560 + h * 128; bf16_t* mrow = A.mixed + (size_t)tok0 * 1024 + 512 + h * 128;
        unsigned goff = (unsigned)(4 * hi * 3072 + r32), moff = (unsigned)(4 * hi * 1024 + r32); asm volatile("" : "+v"(goff), "+v"(moff));
        float ggv[4];
#pragma unroll
        for (int vb = 0; vb < 4; ++vb) ggv[vb] = A.ggain[32 * vb + r32];
        bf16x8 qa[4];
#pragma unroll
        for (int ks = 0; ks < 4; ++ks) qa[ks] = *(const bf16x8*)(A.QT + (size_t)task * 4096 + (32 * tb + r32) * 64 + 16 * ks + 8 * hi);
        f32x16 acc[4];
        f32x4 sfA[8];
#define G3_SLOAD(DST, VB) do { _Pragma("unroll") for (int ks_ = 0; ks_ < 4; ++ks_) { const float* sp_ = A.ST + (size_t)task * 8192 + (32 * (VB) + r32) * 64 + 16 * ks_ + 8 * hi; \
        DST[2 * ks_] = *(const f32x4*)sp_; DST[2 * ks_ + 1] = *(const f32x4*)(sp_ + 4); } } while (0)
#define G3_MMA(SRC, VB) do { _Pragma("unroll") for (int ks_ = 0; ks_ < 4; ++ks_) { const f32x4 f0 = SRC[2 * ks_], f1 = SRC[2 * ks_ + 1]; \
        acc[VB] = __builtin_amdgcn_mfma_f32_32x32x16_bf16(qa[ks_], pack8(f0[0], f0[1], f0[2], f0[3], f1[0], f1[1], f1[2], f1[3]), acc[VB], 0, 0, 0); } } while (0)
#pragma unroll
        for (int vb = 0; vb < 4; ++vb) {
            const u32x4* op = (const u32x4*)((const unsigned*)A.OINTRA + (size_t)task * 4096 + (tb * 4 + vb) * 512 + lane * 8);
#pragma unroll
            for (int q4 = 0; q4 < 2; ++q4) { const u32x4 t4 = op[q4];
                acc[vb][8 * q4] = __uint_as_float(t4.x << 16); acc[vb][8 * q4 + 1] = __uint_as_float(t4.x & 0xffff0000u); acc[vb][8 * q4 + 2] = __uint_as_float(t4.y << 16); acc[vb][8 * q4 + 3] = __uint_as_float(t4.y & 0xffff0000u);
                acc[vb][8 * q4 + 4] = __uint_as_float(t4.z << 16); acc[vb][8 * q4 + 5] = __uint_as_float(t4.z & 0xffff0000u); acc[vb][8 * q4 + 6] = __uint_as_float(t4.w << 16); acc[vb][8 * q4 + 7] = __uint_as_float(t4.w & 0xffff0000u); }
        }
#pragma unroll
        for (int vb = 0; vb < 4; ++vb) { G3_SLOAD(sfA, vb); __builtin_amdgcn_sched_barrier(0); G3_MMA(sfA, vb); __builtin_amdgcn_sched_barrier(0); }
#undef G3_SLOAD
#undef G3_MMA
        bf16_t gt[4][16];
#pragma unroll
        for (int vb = 0; vb < 4; ++vb)
#pragma unroll
            for (int r = 0; r < 16; ++r) gt[vb][r] = grow[goff + (unsigned)(((r & 3) + 8 * (r >> 2)) * 3072 + 32 * vb)];
        float rstd[16];
#pragma unroll
        for (int r = 0; r < 16; ++r) { float ss = 0.f;
#pragma unroll
            for (int vb = 0; vb < 4; ++vb) ss += acc[vb][r] * acc[vb][r];
            rstd[r] = ss; }
#pragma unroll
        for (int o = 1; o < 32; o <<= 1) {
#pragma unroll
            for (int r = 0; r < 16; ++r) rstd[r] += __shfl_xor(rstd[r], o);
            __builtin_amdgcn_sched_barrier(0); }
#pragma unroll
        for (int r = 0; r < 16; ++r) rstd[r] = rsqrtf(rstd[r] * (1.0f / 128.0f) + RMS_EPS);
#pragma unroll
        for (int vb = 0; vb < 4; ++vb) { const float gg = ggv[vb];
#pragma unroll
            for (int r = 0; r < 16; ++r) { const int rr = (r & 3) + 8 * (r >> 2);
                const float gate = bf2f(gt[vb][r]);
                const float sg = gate * __builtin_amdgcn_rcpf(1.0f + __builtin_amdgcn_exp2f(-gate * LOG2E));
                mrow[moff + (unsigned)(rr * 1024 + 32 * vb)] = f2bf(acc[vb][r] * rstd[r] * gg * sg); } }
    }
}
constexpr int AT_K = 0, AT_V = 2 * 64 * RS, AT_STAGE = AT_V + 128 * RS;
constexpr int AT_WSF = 65536;
struct AttnArgs { const bf16_t* proj; const bf16_t* vt; bf16_t* mixed; const float *qg, *kg, *lq1, *lk1, *lq2, *lk2, *dgain; float* parto; float* partl; };
__device__ __forceinline__ int attn_kt0(int h, int qb, float TH) { const float slope2 = exp2f(-2.0f * (float)(h + 1)) * LOG2E; const float v = floorf(((float)(128 * qb - 63) - TH / slope2) * (1.0f / 64.0f)) + 1.0f; return v > 0.f ? (int)v : 0; }
constexpr int SEGT = 64;
__device__ __forceinline__ bool attn_split(int h, int qb, int nt_eff) { return h >= 2 && qb >= 32 && nt_eff > SEGT; }
__device__ __forceinline__ int attn_slot(int b, int h, int qb) { return (b * 2 + (h - 2)) * 32 + (qb - 32); }
__device__ __forceinline__ bool attn_item(LAS unsigned char* lds, const AttnArgs& A, int it, float lam, float M2) {
    int tid_ = threadIdx.x; asm volatile("" : "+v"(tid_)); const int tid = tid_, lane = tid & 63, wid = __builtin_amdgcn_readfirstlane(tid >> 6), r32 = lane & 31, hi = lane >> 5;
    const int g = wid >> 2, w = wid & 3;
    int qb, bh, seg;
    if (it < 384) { qb = 63 - it / 12; const int j = it % 12; if (j < 8) { bh = j; seg = 0; } else { bh = ((j - 8) >> 1) * 4 + 2 + ((j - 8) & 1); seg = 1; } }
    else { const int i2 = it - 384; qb = 31 - (i2 >> 3); bh = i2 & 7; seg = 0; }
    const int b = bh >> 2, h = bh & 3;
    const float TH = 2.0f * M2 + 53.0f;
    const int ntile_all = 2 * qb + 2, kt0 = attn_kt0(h, qb, TH), nt_eff = ntile_all - kt0;
    const bool split = attn_split(h, qb, nt_eff);
    int kt_begin = kt0, kt_end = ntile_all;
    if (split) { const int half = nt_eff >> 1; if (seg == 0) kt_end = kt0 + half; else kt_begin = kt0 + half; }
    else if (seg == 1) return false;
    int kgo[2], klo[2], vgo[2], vlo[2];
#pragma unroll
    for (int i = 0; i < 2; ++i) { const int idx = tid + NTHR * i; const int krow = idx >> 4, kch = idx & 15; kgo[i] = krow * 3072 + kch * 8; klo[i] = AT_K + (kch >> 3) * (64 * RS) + krow * RS + (kch & 7) * 16;
        const int vrow = idx >> 3, vch = idx & 7; vgo[i] = vrow * SEQ + vch * 8; vlo[i] = AT_V + vrow * RS + vch * 16; }
    {
        const float slope2 = exp2f(-2.0f * (float)(h + 1)) * LOG2E;
        const bf16_t* Kg = A.proj + (size_t)b * SEQ * 3072 + 512 + h * 128;
        const bf16_t* Vg = A.vt + (size_t)bh * 128 * SEQ;
        {
            const int q0 = qb * 128;
            const int qpos = q0 + 32 * w + r32;
            bf16x8 qf[4];
#pragma unroll
            for (int ds = 0; ds < 4; ++ds) qf[ds] = *(const bf16x8*)(A.proj + ((size_t)b * SEQ + qpos) * 3072 + h * 128 + g * 64 + 16 * ds + 8 * hi);
            u32x4 kr[2], vr[2];
#pragma unroll
            for (int i = 0; i < 2; ++i) { kr[i] = *(const u32x4*)(Kg + (size_t)(64 * kt_begin) * 3072 + kgo[i]); vr[i] = *(const u32x4*)(Vg + 64 * kt_begin + vgo[i]); }
#pragma unroll
            for (int i = 0; i < 2; ++i) { *(LAS u32x4*)(lds + klo[i]) = kr[i]; *(LAS u32x4*)(lds + vlo[i]) = vr[i]; }
            __syncthreads();
            f32x16 O[4]; O[0] = f32x16{}; O[1] = f32x16{}; O[2] = f32x16{}; O[3] = f32x16{};
            float l = 0.f;
            float cr8[8];
#pragma unroll
            for (int j = 0; j < 8; ++j) cr8[j] = -slope2 * (float)(qpos - (8 * hi + j)) - M2;
            for (int t = kt_begin; t < kt_end; ++t) {
                const int k0 = 64 * t; const bool more = t + 1 < kt_end;
                if (more) {
#pragma unroll
                    for (int i = 0; i < 2; ++i) { kr[i] = *(const u32x4*)(Kg + (size_t)(k0 + 64) * 3072 + kgo[i]); vr[i] = *(const u32x4*)(Vg + (k0 + 64) + vgo[i]); }
                }
                const LAS unsigned char* sp = lds + ((t - kt_begin) & 1) * AT_STAGE;
                if (k0 <= q0 + 32 * w + 31) {
                    bf16x8 kf[8];
#pragma unroll
                    for (int blk = 0; blk < 2; ++blk)
#pragma unroll
                        for (int ds = 0; ds < 4; ++ds) kf[blk * 4 + ds] = *(const LAS bf16x8*)(sp + AT_K + g * (64 * RS) + (32 * blk + pi_row(r32)) * RS + (16 * ds + 8 * hi) * 2);
                    __builtin_amdgcn_sched_barrier(0);
                    f32x16 S[2];
#pragma unroll
                    for (int blk = 0; blk < 2; ++blk) {
                        const float off0 = slope2 * (float)(k0 + 32 * blk), off1 = slope2 * (float)(k0 + 32 * blk + 16);
#pragma unroll
                        for (int r = 0; r < 16; ++r) S[blk][r] = cr8[r & 7] + ((r >> 3) ? off1 : off0);
                    }
#pragma unroll
                    for (int ds = 0; ds < 4; ++ds)
#pragma unroll
                        for (int blk = 0; blk < 2; ++blk) S[blk] = __builtin_amdgcn_mfma_f32_32x32x16_bf16(kf[blk * 4 + ds], qf[ds], S[blk], 0, 0, 0);
                    bf16x8 vfA[4], vfB[4];
#pragma unroll
                    for (int ks = 0; ks < 4; ++ks) vfA[ks] = *(const LAS bf16x8*)(sp + AT_V + r32 * RS + (16 * ks + 8 * hi) * 2);
                    __builtin_amdgcn_sched_barrier(0);
                    const bool needmask = k0 + 63 > q0 + 32 * w;
                    const int dlim = qpos - k0 - 8 * hi;
                    float ls = 0.f;
                    if (needmask) {
#pragma unroll
                        for (int blk = 0; blk < 2; ++blk)
#pragma unroll
                            for (int r = 0; r < 16; ++r) { float pv = __builtin_amdgcn_exp2f(S[blk][r]);
                                if ((32 * blk + 16 * (r >> 3) + (r & 7)) > dlim) pv = 0.f;
                                S[blk][r] = pv; ls += pv; }
                    } else {
                        float ls1 = 0.f;
#pragma unroll
                        for (int blk = 0; blk < 2; ++blk)
#pragma unroll
                            for (int r = 0; r < 16; r += 2) { const float p0 = __builtin_amdgcn_exp2f(S[blk][r]), p1 = __builtin_amdgcn_exp2f(S[blk][r + 1]); S[blk][r] = p0; S[blk][r + 1] = p1; ls += p0; ls1 += p1; }
                        ls += ls1;
                    }
                    l += ls;
                    bf16x8 P[4];
#pragma unroll
                    for (int blk = 0; blk < 2; ++blk) { P[2 * blk] = pack8(S[blk][0], S[blk][1], S[blk][2], S[blk][3], S[blk][4], S[blk][5], S[blk][6], S[blk][7]);
                        P[2 * blk + 1] = pack8(S[blk][8], S[blk][9], S[blk][10], S[blk][11], S[blk][12], S[blk][13], S[blk][14], S[blk][15]); }
#pragma unroll
                    for (int vb = 0; vb < 4; ++vb) {
                        if (vb < 3) {
#pragma unroll
                            for (int ks = 0; ks < 4; ++ks) vfB[ks] = *(const LAS bf16x8*)(sp + AT_V + (32 * (vb + 1) + r32) * RS + (16 * ks + 8 * hi) * 2);
                        }
                        __builtin_amdgcn_sched_barrier(0);
#pragma unroll
                        for (int ks = 0; ks < 4; ++ks) O[vb] = __builtin_amdgcn_mfma_f32_32x32x16_bf16(P[ks], vfA[ks], O[vb], 0, 0, 0);
                        __builtin_amdgcn_sched_barrier(0);
#pragma unroll
                        for (int ks = 0; ks < 4; ++ks) vfA[ks] = vfB[ks];
                    }
                }
                if (more) { LAS unsigned char* dp = lds + ((t + 1 - kt_begin) & 1) * AT_STAGE;
#pragma unroll
                    for (int i = 0; i < 2; ++i) { *(LAS u32x4*)(dp + klo[i]) = kr[i]; *(LAS u32x4*)(dp + vlo[i]) = vr[i]; } }
                __syncthreads();
            }
            l += __shfl_xor(l, 32);
            if (split) {
                const int slot = attn_slot(b, h, qb); const size_t pidx = (size_t)((slot * 2 + seg) * 2 + g) * 4 + w;
                float* po = A.parto + pidx * 4096 + lane;
#pragma unroll
                for (int vb = 0; vb < 4; ++vb)
#pragma unroll
                    for (int r = 0; r < 16; ++r) po[(vb * 16 + r) * 64] = O[vb][r];
                if (hi == 0) A.partl[pidx * 32 + r32] = l;
                return true;
            }
            float dgv[4];
#pragma unroll
            for (int vb = 0; vb < 4; ++vb) dgv[vb] = A.dgain[32 * vb + r32] * 0.8f;
            LAS float* wsf = (LAS float*)(lds + AT_WSF) + wid * 32;
            if (hi == 0) wsf[r32] = 1.0f / l;
            asm volatile("s_waitcnt lgkmcnt(0)" ::: "memory");
            float rl[16];
#pragma unroll
            for (int r = 0; r < 16; ++r) rl[r] = wsf[crow(r, hi)];
            LAS float* X = (LAS float*)lds + (size_t)w * 64 * 64 + lane;
            if (g == 1) {
#pragma unroll
                for (int vb = 0; vb < 4; ++vb)
#pragma unroll
                    for (int r = 0; r < 16; ++r) X[(vb * 16 + r) * 64] = lam * O[vb][r] * rl[r];
            }
            __syncthreads();
            if (g == 0) {
                float rstd[16];
#pragma unroll
                for (int r = 0; r < 16; ++r) { float ss = 0.f;
#pragma unroll
                    for (int vb = 0; vb < 4; ++vb) { const float o = O[vb][r] * rl[r] - X[(vb * 16 + r) * 64]; O[vb][r] = o; ss += o * o; }
                    rstd[r] = ss; }
#pragma unroll
                for (int o = 1; o < 32; o <<= 1) {
#pragma unroll
                    for (int r = 0; r < 16; ++r) rstd[r] += __shfl_xor(rstd[r], o);
                    __builtin_amdgcn_sched_barrier(0); }
#pragma unroll
                for (int r = 0; r < 16; ++r) rstd[r] = rsqrtf(rstd[r] * (1.0f / 128.0f) + RMS_EPS);
                bf16_t* mrow = A.mixed + ((size_t)b * SEQ + q0 + 32 * w) * 1024 + h * 128;
                unsigned loff = (unsigned)(4 * hi * 1024 + r32); asm volatile("" : "+v"(loff));
#pragma unroll
                for (int vb = 0; vb < 4; ++vb) { const float dg = dgv[vb];
#pragma unroll
                    for (int r = 0; r < 16; ++r) mrow[loff + (unsigned)(((r & 3) + 8 * (r >> 2)) * 1024 + 32 * vb)] = f2bf(O[vb][r] * rstd[r] * dg); }
            }
            __syncthreads();
        }
    }
    return false;
}
__device__ __forceinline__ void attn_finalize(const AttnArgs& A, int wt, float lam, float M2) {
    int tid_ = threadIdx.x; asm volatile("" : "+v"(tid_)); const int lane = tid_ & 63, r32 = lane & 31, hi = lane >> 5;
    const int slot = wt >> 2, w = wt & 3; const int b = slot >> 6, h = 2 + ((slot >> 5) & 1), qb = 32 + (slot & 31);
    const float TH = 2.0f * M2 + 53.0f; const int nt_eff = 2 * qb + 2 - attn_kt0(h, qb, TH);
    if (!attn_split(h, qb, nt_eff)) return;
    float rl[2][16];
#pragma unroll
    for (int g = 0; g < 2; ++g)
#pragma unroll
        for (int r = 0; r < 16; ++r) { const int q = crow(r, hi); rl[g][r] = 1.0f / (A.partl[((size_t)((slot * 2 + 0) * 2 + g) * 4 + w) * 32 + q] + A.partl[((size_t)((slot * 2 + 1) * 2 + g) * 4 + w) * 32 + q]); }
    float dgv[4];
#pragma unroll
    for (int vb = 0; vb < 4; ++vb) dgv[vb] = A.dgain[32 * vb + r32];
    float o[4][16]; float rstd[16];
#pragma unroll
    for (int r = 0; r < 16; ++r) { float ss = 0.f;
#pragma unroll
        for (int vb = 0; vb < 4; ++vb) { const int e = (vb * 16 + r) * 64 + lane;
            const float o0 = A.parto[((size_t)((slot * 2 + 0) * 2 + 0) * 4 + w) * 4096 + e] + A.parto[((size_t)((slot * 2 + 1) * 2 + 0) * 4 + w) * 4096 + e];
            const float o1 = A.parto[((size_t)((slot * 2 + 0) * 2 + 1) * 4 + w) * 4096 + e] + A.parto[((size_t)((slot * 2 + 1) * 2 + 1) * 4 + w) * 4096 + e];
            const float v = o0 * rl[0][r] - lam * o1 * rl[1][r]; o[vb][r] = v; ss += v * v; }
        rstd[r] = ss; }
#pragma unroll
    for (int x = 1; x < 32; x <<= 1) {
#pragma unroll
        for (int r = 0; r < 16; ++r) rstd[r] += __shfl_xor(rstd[r], x);
        __builtin_amdgcn_sched_barrier(0); }
#pragma unroll
    for (int r = 0; r < 16; ++r) rstd[r] = rsqrtf(rstd[r] * (1.0f / 128.0f) + RMS_EPS);
    bf16_t* mrow = A.mixed + ((size_t)b * SEQ + qb * 128 + 32 * w) * 1024 + h * 128;
    unsigned loff = (unsigned)(4 * hi * 1024 + r32); asm volatile("" : "+v"(loff));
#pragma unroll
    for (int vb = 0; vb < 4; ++vb) { const float dg = dgv[vb] * 0.8f;
#pragma unroll
        for (int r = 0; r < 16; ++r) mrow[loff + (unsigned)(((r & 3) + 8 * (r >> 2)) * 1024 + 32 * vb)] = f2bf(o[vb][r] * rstd[r] * dg); }
}
__device__ __forceinline__ void attn_consts(const AttnArgs& A, float& lam, float& M2) {
    int tid_ = threadIdx.x; asm volatile("" : "+v"(tid_)); const int lane = tid_ & 63;
    lam = __expf(wave_sum(A.lq1[lane] * A.lk1[lane])) - __expf(wave_sum(A.lq2[lane] * A.lk2[lane])) + 0.2f;
    M2 = 8.0f * wave_max(fabsf(A.qg[lane])) * wave_max(fabsf(A.kg[lane])) * LOG2E;
    lam = __uint_as_float(__builtin_amdgcn_readfirstlane(__float_as_uint(lam))); M2 = __uint_as_float(__builtin_amdgcn_readfirstlane(__float_as_uint(M2)));
}
#define XB_TMO      128
#define XB_XCNT(j)  (256  + 64 * (j))
#define XB_XSUB(j)  (1280 + 64 * (j))
#define XB_XGEN(j)  (2304 + 64 * (j))
#define XB_TOP      3328
#define XB_TOPGEN   3392
#define XCD_BAR_WORDS 3456
#define XB_SPIN_CAP (1u << 18)

__device__ __forceinline__ unsigned xb_ld(unsigned* p)              { return __hip_atomic_load(p, __ATOMIC_RELAXED, __HIP_MEMORY_SCOPE_AGENT); }
__device__ __forceinline__ unsigned xb_add(unsigned* p, unsigned v) { return __hip_atomic_fetch_add(p, v, __ATOMIC_RELAXED, __HIP_MEMORY_SCOPE_AGENT); }
__device__ __forceinline__ unsigned xb_xcc_id() { return (unsigned)__builtin_amdgcn_s_getreg((3 << 11) | 20) & 0xFu; }
#define XB_SPIN(cond, bar) do { unsigned _sp = 0; while (cond) { __builtin_amdgcn_s_sleep(1); \
    if ((++_sp & 255u) == 0u) { if (xb_ld(&(bar)[XB_TMO])) break; if (_sp > XB_SPIN_CAP) { atomicAdd(&(bar)[XB_TMO], 1u); break; } } } } while (0)

struct XcdBarrier {
    unsigned* bar; unsigned x;
    volatile LAS unsigned* st;
};

__device__ __forceinline__ XcdBarrier xcd_barrier_post(unsigned* bar, volatile LAS unsigned* st) {
    XcdBarrier b; b.bar = bar; b.x = xb_xcc_id(); b.st = st;
    if (threadIdx.x == 0) (void)xb_add(&bar[XB_XCNT(b.x)], 1u);
    return b;
}
__device__ __forceinline__ void xcd_barrier_complete(unsigned* bar, unsigned x, unsigned& nloc, unsigned& nx) {
    const unsigned G = gridDim.x * gridDim.y * gridDim.z;
    unsigned sum, cnt, mine, sp = 0u;
    for (;;) {
        sum = 0u; cnt = 0u; mine = 0u;
#pragma unroll
        for (unsigned j = 0; j < 16; ++j) { const unsigned c = xb_ld(&bar[XB_XCNT(j)]); sum += c; cnt += (c > 0u) ? 1u : 0u; mine = (j == x) ? c : mine; }
        if (sum == G) break;
        __builtin_amdgcn_s_sleep(1);
        if ((++sp & 255u) == 0u) { if (xb_ld(&bar[XB_TMO])) break; if (sp > XB_SPIN_CAP) { atomicAdd(&bar[XB_TMO], 1u); break; } }
    }
    nloc = mine > 0u ? mine : 1u; nx = cnt > 0u ? cnt : 1u;
}

__device__ __forceinline__ void xcd_barrier(const XcdBarrier& b) {
    asm volatile("s_waitcnt vmcnt(0)" ::: "memory");
    __syncthreads();
    if (threadIdx.x == 0) {
        unsigned* bar = b.bar;
        __builtin_amdgcn_s_waitcnt(0);
        unsigned nloc = b.st[0], nx = b.st[1];
        if (nloc == 0u) { xcd_barrier_complete(bar, b.x, nloc, nx); b.st[0] = nloc; b.st[1] = nx; }
        const unsigned old = xb_add(&bar[XB_XSUB(b.x)], 1u);
        const unsigned gen = old / nloc;
        if (old + 1u == (gen + 1u) * nloc) {
            __builtin_amdgcn_fence(__ATOMIC_RELEASE, "agent");
            asm volatile("s_waitcnt vmcnt(0)" ::: "memory");
            const unsigned og = xb_add(&bar[XB_TOP], 1u);
            const unsigned tg = og / nx;
            if (og + 1u == (tg + 1u) * nx) xb_add(&bar[XB_TOPGEN], 1u);
            else XB_SPIN(xb_ld(&bar[XB_TOPGEN]) == tg, bar);
            __builtin_amdgcn_fence(__ATOMIC_ACQUIRE, "agent");
            xb_add(&bar[XB_XGEN(b.x)], 1u);
            asm volatile("s_waitcnt vmcnt(0)" ::: "memory");
        } else {
            XB_SPIN(xb_ld(&bar[XB_XGEN(b.x)]) == gen, bar);
            __builtin_amdgcn_fence(__ATOMIC_ACQUIRE, "agent");
            asm volatile("s_waitcnt vmcnt(0)" ::: "memory");
        }
    }
    __syncthreads();
}

constexpr int MISC_OFF = 131072 + 320;
#ifndef MK_N_LAUNCHES
#define MK_N_LAUNCHES 1
#endif
constexpr int NPHASE = 9;
struct Args { const float* in[18]; float* out; unsigned char* ws; int ph_lo, ph_hi; };
__global__ void __launch_bounds__(NTHR, 2) fwd_megakernel(Args a) {
    extern __shared__ __attribute__((aligned(16))) unsigned char lds_raw[];
    LAS unsigned char* lds = (LAS unsigned char*)lds_raw;
    cg::grid_group grid = cg::this_grid();
    const int G = gridDim.x, bid = blockIdx.x;
    unsigned char* ws = a.ws;
    volatile LAS unsigned* MISC = (volatile LAS unsigned*)(lds + MISC_OFF);
    if (threadIdx.x < 32) MISC[threadIdx.x] = 0u;
    __syncthreads();
    XcdBarrier bar = xcd_barrier_post((unsigned*)(ws + WS_BAR), MISC + 8);
    if (a.ph_lo < 0) grid.sync();
    const float* x = a.in[0];
    bf16_t* WinT = (bf16_t*)(ws + WS_WIN); bf16_t* WoT = (bf16_t*)(ws + WS_WO); bf16_t* WguT = (bf16_t*)(ws + WS_WGU); bf16_t* WdT = (bf16_t*)(ws + WS_WD);
    float* glr = (float*)(ws + WS_GLR); float* dvec = (float*)(ws + WS_DVEC); float* rowss = (float*)(ws + WS_ROWSS);
    bf16_t* XN = (bf16_t*)(ws + WS_XN); bf16_t* PROJ = (bf16_t*)(ws + WS_PROJ); bf16_t* VT = (bf16_t*)(ws + WS_VT); bf16_t* GVT = (bf16_t*)(ws + WS_GVT);
    bf16_t* MIX = (bf16_t*)(ws + WS_MIX); float* ST = (float*)(ws + WS_ST);
    float* OINTRA = a.out; bf16_t* QT = (bf16_t*)((unsigned char*)a.out + 32 * MiB);
    bf16_t* HB = XN; bf16_t* HID = PROJ;
    float* PARTO = (float*)(ws + WS_XN); float* PARTL = (float*)((unsigned char*)a.out + 40 * MiB);
    const int lo = a.ph_lo, hi = a.ph_hi;
#define IN(k) (lo <= (k) && (k) < hi)
#ifndef REPEAT_MASK
#define REPEAT_MASK 0
#endif
#define REP(k) (((REPEAT_MASK >> (k)) & 1) ? 2 : 1)
#define SEAM(k) do { if (IN(k) && IN((k) + 1)) xcd_barrier(bar); } while (0)
    if (IN(0)) for (int rep_ = 0; rep_ < REP(0); ++rep_) { P0Args P{x, a.in[1], a.in[2], a.in[13], a.in[14], a.in[15], a.in[16], a.in[17], WinT, WoT, WguT, WdT, XN, glr, rowss}; p0_prologue(lds, P, G, bid); }
    SEAM(0);
    if (IN(1)) for (int rep_ = 0; rep_ < REP(1); ++rep_) { pg8::Gemm g{XN, WinT, M, 3072, 1024}; pg8::StaticOrder S; S.init(M, 3072, G, bid);
        pg8::EpiInProj E{PROJ, VT, GVT, a.in[3], a.in[4]};
        pg8::gemm_phase<pg8::EpiInProj, pg8::StaticOrder, true, true>(lds, g, S, E); }
    SEAM(1);
    if (IN(2)) { GlaArgs GA{PROJ, GVT, glr, a.in[10], a.in[11], QT, OINTRA, ST, dvec}; Gla3Args GB{PROJ, QT, OINTRA, ST, a.in[12], MIX};
        AttnArgs AA{PROJ, VT, MIX, a.in[3], a.in[4], a.in[5], a.in[6], a.in[7], a.in[8], a.in[9], PARTO, PARTL};
        P0Args PW{x, a.in[1], a.in[2], a.in[13], a.in[14], a.in[15], a.in[16], a.in[17], WinT, WoT, WguT, WdT, XN, glr, rowss};
        float lam, M2; attn_consts(AA, lam, M2);
        unsigned* qhead = (unsigned*)(ws + WS_QHEAD); unsigned* g1done = qhead + 64; unsigned* scandone = qhead + 128; unsigned* splitdone = qhead + 192;
        const int wid_ = __builtin_amdgcn_readfirstlane(threadIdx.x >> 6);
        int nsplit;
        { const float TH = 2.0f * M2 + 53.0f; const int l_ = threadIdx.x & 63; float sp_ = 0.f;
#pragma unroll
          for (int q_ = 0; q_ < 2; ++q_) { const int t_ = l_ + 64 * q_; const int h_ = 2 + ((t_ >> 5) & 1), qb_ = 32 + (t_ & 31); sp_ += attn_split(h_, qb_, 2 * qb_ + 2 - attn_kt0(h_, qb_, TH)) ? 1.f : 0.f; }
          nsplit = __builtin_amdgcn_readfirstlane((int)(wave_sum(sp_) + 0.5f)); }
        constexpr int Q_A1 = 256, Q_SC = Q_A1 + 256, Q_A2 = Q_SC + 128, Q_FN = Q_A2 + 384, Q_G3 = Q_FN + 64, Q_LW = Q_G3 + 256, Q_END = Q_LW + LW_BLOCK_ITEMS;
        unsigned nxt_ = 0u;
        if (threadIdx.x == 0) nxt_ = __hip_atomic_fetch_add(qhead, 1u, __ATOMIC_RELAXED, __HIP_MEMORY_SCOPE_AGENT);
        for (;;) {
            if (threadIdx.x == 0) MISC[0] = nxt_;
            __syncthreads();
            const int it = __builtin_amdgcn_readfirstlane((int)MISC[0]);
            __syncthreads();
            if (it >= Q_END) break;
            const int ty = it < Q_A1 ? 0 : it < Q_SC ? 1 : it < Q_A2 ? 2 : it < Q_FN ? 1 : it < Q_G3 ? 3 : it < Q_LW ? 4 : 5;
            unsigned* wcnt = ty == 2 ? g1done : ty == 3 ? splitdone : ty == 4 ? scandone : nullptr;
            const unsigned want = ty == 2 ? 256u : ty == 3 ? 2u * (unsigned)nsplit : 128u;
            item_wait(wcnt, want);
            unsigned* dcnt = nullptr;
            if (ty == 0) { gla_chunk_quad(lds, GA, 4 * it); dcnt = g1done; }
            else if (ty == 1) { const int ai = it < Q_SC ? it - Q_A1 : it - Q_A2 + 256; if (attn_item(lds, AA, ai, lam, M2)) dcnt = splitdone; }
            else if (ty == 2) { gla_scan_item(ST, dvec, it - Q_SC); dcnt = scandone; }
            else if (ty == 3) attn_finalize(AA, (it - Q_FN) * NWAVES + wid_, lam, M2);
            else if (ty == 4) gla_out_task(GB, (it - Q_G3) * NWAVES + wid_);
            else late_weights_item(lds, PW, it - Q_LW);
            if (threadIdx.x == 0) nxt_ = __hip_atomic_fetch_add(qhead, 1u, __ATOMIC_RELAXED, __HIP_MEMORY_SCOPE_AGENT);
            item_done(dcnt);
        }
    }
    SEAM(2);
    if (IN(6)) for (int rep_ = 0; rep_ < REP(6); ++rep_) { pg8::Gemm g{MIX, WoT, M, 1024, 1024}; pg8::StaticOrder S; S.init(M, 1024, G, bid);
        pg8::EpiOut E{x, a.out, HB, rowss};
        pg8::gemm_phase<pg8::EpiOut, pg8::StaticOrder, false, true>(lds, g, S, E); }
    SEAM(6);
    if (IN(7)) for (int rep_ = 0; rep_ < REP(7); ++rep_) { pg8::Gemm g{HB, WguT, M, 2 * DFF, 1024}; pg8::StaticOrder S; S.init(M, 2 * DFF, G, bid);
        pg8::EpiSwiGLU E{HID, rowss};
        pg8::gemm_phase<pg8::EpiSwiGLU, pg8::StaticOrder, true, true>(lds, g, S, E); }
    SEAM(7);
    if (IN(8)) for (int rep_ = 0; rep_ < REP(8); ++rep_) { pg8::Gemm g{HID, WdT, M, 1024, DFF}; pg8::StaticOrder S; S.init(M, 1024, G, bid);
        pg8::EpiDown E{a.out, HB};
        pg8::gemm_phase<pg8::EpiDown, pg8::StaticOrder, false, true>(lds, g, S, E); }
#undef IN
#undef SEAM
}

extern "C" void kernel_launch(void* const* d_in, const int* in_sizes, int n_in, void* d_out, int out_size, void* d_ws, size_t ws_size, hipStream_t stream) {
    static int grid = 0;
    if (grid == 0) {
        if (n_in != 18 || out_size != M * DM || ws_size < WS_END) { fprintf(stderr, "kernel_launch: unexpected shapes (n_in %d, out %d, ws %zu)\n", n_in, out_size, ws_size); grid = -1; return; }
        int dev = 0, cus = 0, per_cu = 0;
        hipGetDevice(&dev); hipDeviceGetAttribute(&cus, hipDeviceAttributeMultiprocessorCount, dev);
        hipFuncSetAttribute((const void*)fwd_megakernel, hipFuncAttributeMaxDynamicSharedMemorySize, LDS_BYTES);
        if (hipOccupancyMaxActiveBlocksPerMultiprocessor(&per_cu, (const void*)fwd_megakernel, NTHR, LDS_BYTES) != hipSuccess || per_cu < 1) per_cu = 1;
        (void)hipGetLastError();
        grid = cus * per_cu;
        if (grid < 1) grid = 256;
    }
    if (grid < 0) return;
    if (hipMemsetAsync((char*)d_ws + WS_BAR, 0, 16384, stream) != hipSuccess) { fprintf(stderr, "kernel_launch: memset failed\n"); return; }
    Args a{};
    for (int i = 0; i < 18; ++i) a.in[i] = (const float*)d_in[i];
    a.out = (float*)d_out; a.ws = (unsigned char*)d_ws;
#if MK_N_LAUNCHES == 1
    a.ph_lo = 0; a.ph_hi = NPHASE;
    void* args[] = {&a};
    hipError_t e = hipLaunchCooperativeKernel((const void*)fwd_megakernel, dim3(grid), dim3(NTHR), args, LDS_BYTES, stream);
    if (e != hipSuccess) fprintf(stderr, "cooperative launch failed: %s (grid %d)\n", hipGetErrorString(e), grid);
#else
    for (int ph = 0; ph < NPHASE; ++ph) { a.ph_lo = ph; a.ph_hi = ph + 1; hipLaunchKernelGGL(fwd_megakernel, dim3(grid), dim3(NTHR), LDS_BYTES, stream, a); }
#endif
}
```

```cpp
#include <hip/hip_runtime.h>
#include <hip/hip_cooperative_groups.h>
#include <cstdio>
#include <cstdint>
namespace cg = cooperative_groups;
#define MK_N_LAUNCHES 1
#define REPEAT_MASK 0

namespace pg8 {
#define PG8_LAS __attribute__((address_space(3)))
typedef unsigned short bf16_t;
typedef short bf16x8 __attribute__((ext_vector_type(8)));
typedef float f32x4 __attribute__((ext_vector_type(4)));
typedef unsigned u32x4 __attribute__((ext_vector_type(4)));
constexpr int BM = 256, BK = 64, HALF = 128, HTB = HALF * BK * 2  , STAGE_BYTES = 8 * HTB, NXCD = 8, WGM = 8;

__host__ __device__ __forceinline__ int lds_byte(int r, int c) { const int st = (r >> 4) * 2 + (c >> 5), rr = r & 15, cc = c & 31, ob = rr * 64 + cc * 2; return st * 1024 + (ob ^ (((ob >> 9) & 1) << 5)); }
__host__ __device__ __forceinline__ void stage_rc(int b, int& R, int& C) { const int st = b / 1024, sb = b % 1024, swz = sb ^ (((sb >> 9) & 1) << 5); R = (st >> 1) * 16 + swz / 64; C = (st & 1) * 32 + (swz % 64) / 2; }
__host__ __device__ __forceinline__ int perm32(int rho) { const int n = rho >> 4, i = rho & 15; return 8 * (i >> 2) + 4 * n + (i & 3); }

struct Unit { int pm, pn; };
struct Gemm { const bf16_t* A; const bf16_t* Bt; int M, N, K; };

struct StaticOrder {
    int nM, nN, nwg, G, c;
    __host__ __device__ void init(int M, int N, int G_, int c_) { nM = M / BM; nN = N / BM; nwg = nM * nN; G = G_; c = c_; }
    __host__ __device__ bool next(int i, Unit& u) const {
        const long L = (long)i * G + c; if (L >= nwg) return false;
        int wgid = (int)L; { const int q = nwg / NXCD, r = nwg % NXCD, xcd = wgid % NXCD, off = wgid / NXCD; wgid = (xcd < r ? xcd * (q + 1) : r * (q + 1) + (xcd - r) * q) + off; }
        const int nig = WGM * nN, gid = wgid / nig, fm = gid * WGM, gsz = (nM - fm) < WGM ? (nM - fm) : WGM;
        u.pm = fm + ((wgid % nig) % gsz); u.pn = (wgid % nig) / gsz; return true;
    }
    __device__ __forceinline__ void a_ready(const Unit&) const {}
    __device__ __forceinline__ void done(const Unit&) const {}
};

__device__ __forceinline__ unsigned cvt_pk_bf16(float lo, float hi) { unsigned r; asm volatile("v_cvt_pk_bf16_f32 %0, %1, %2" : "=v"(r) : "v"(lo), "v"(hi)); return r; }
typedef float f32x2 __attribute__((ext_vector_type(2)));
typedef unsigned u32x2 __attribute__((ext_vector_type(2)));
typedef float f32x2_t __attribute__((ext_vector_type(2))); typedef __bf16 bf16x2_t __attribute__((ext_vector_type(2)));
__device__ __forceinline__ unsigned cvtpk(float lo, float hi) { f32x2_t v = {lo, hi}; bf16x2_t b = __builtin_convertvector(v, bf16x2_t); return __builtin_bit_cast(unsigned, b); }
constexpr float RMS_EPS = 1e-6f;
constexpr float LOG2E = 1.4426950408889634f;
constexpr int PROJ_LD = 3072;

struct EpiInProj {
    static constexpr bool PERM = true, AFTER_DRAIN = false;
    bf16_t* proj; bf16_t* vt; bf16_t* gvt; const float* qg; const float* kg;
    __device__ __forceinline__ void operator()(const f32x4 (&acc)[2][2][4][2], const Unit& u, int wr, int wc, int fr, int fq) const {
        const int pn = u.pn; const int row0 = u.pm * BM + wr * 64 + fr;
        if (pn < 4) {
            const float* g = pn < 2 ? qg : kg; const float sc = pn < 2 ? 0.125f * LOG2E : 1.0f;
            f32x4 gv[2][2];
#pragma unroll
            for (int bj = 0; bj < 2; ++bj)
#pragma unroll
                for (int n = 0; n < 2; ++n) gv[bj][n] = *(const f32x4*)(g + 32 * bj + 8 * fq + 4 * n) * sc;
#pragma unroll
            for (int ai = 0; ai < 2; ++ai)
#pragma unroll
                for (int m = 0; m < 4; ++m) {
                    float ss = 0.f;
#pragma unroll
                    for (int bj = 0; bj < 2; ++bj)
#pragma unroll
                        for (int n = 0; n < 2; ++n) { const f32x4 x = acc[ai][bj][m][n]; ss += (x[0] * x[0] + x[1] * x[1]) + (x[2] * x[2] + x[3] * x[3]); }
                    ss += __shfl_xor(ss, 16); ss += __shfl_xor(ss, 32);
                    const float rstd = rsqrtf(ss * (1.0f / 64.0f) + RMS_EPS);
                    bf16_t* rowp = proj + (size_t)(row0 + ai * HALF + m * 16) * PROJ_LD + pn * 256 + wc * 64 + 8 * fq;
#pragma unroll
                    for (int bj = 0; bj < 2; ++bj) { const f32x4 v0 = acc[ai][bj][m][0] * rstd * gv[bj][0], v1 = acc[ai][bj][m][1] * rstd * gv[bj][1];
                        u32x4 w; w.x = cvtpk(v0[0], v0[1]); w.y = cvtpk(v0[2], v0[3]); w.z = cvtpk(v1[0], v1[1]); w.w = cvtpk(v1[2], v1[3]);
                        *(u32x4*)(rowp + 32 * bj) = w; }
                }
        } else if (pn == 4 || pn == 5 || pn == 8 || pn == 9) {
            bf16_t* dst = pn < 6 ? vt : gvt; const int cb = (pn & 1) * 256 + wc * 64 + 8 * fq;
#pragma unroll
            for (int ai = 0; ai < 2; ++ai)
#pragma unroll
                for (int m = 0; m < 4; ++m) { const int row = row0 + ai * HALF + m * 16; const int b = row >> 13, t = row & 8191;
#pragma unroll
                    for (int bj = 0; bj < 2; ++bj)
#pragma unroll
                        for (int n = 0; n < 2; ++n) { const f32x4 x = acc[ai][bj][m][n]; const int c = cb + 32 * bj + 4 * n; const int h = c >> 7, ev = c & 127;
                            bf16_t* p = dst + ((size_t)((b * 4 + h) * 128 + ev)) * 8192 + t; const unsigned w0 = cvtpk(x[0], x[1]), w1 = cvtpk(x[2], x[3]);
                            p[0] = (bf16_t)(w0 & 0xffffu); p[8192] = (bf16_t)(w0 >> 16); p[2 * 8192] = (bf16_t)(w1 & 0xffffu); p[3 * 8192] = (bf16_t)(w1 >> 16); }
                }
        } else {
            const float sc = pn == 6 ? 0.125f : 1.0f;
#pragma unroll
            for (int ai = 0; ai < 2; ++ai)
#pragma unroll
                for (int m = 0; m < 4; ++m) { bf16_t* rowp = proj + (size_t)(row0 + ai * HALF + m * 16) * PROJ_LD + pn * 256 + wc * 64 + 8 * fq;
#pragma unroll
                    for (int bj = 0; bj < 2; ++bj) { const f32x4 v0 = acc[ai][bj][m][0] * sc, v1 = acc[ai][bj][m][1] * sc;
                        u32x4 w; w.x = cvtpk(v0[0], v0[1]); w.y = cvtpk(v0[2], v0[3]); w.z = cvtpk(v1[0], v1[1]); w.w = cvtpk(v1[2], v1[3]);
                        *(u32x4*)(rowp + 32 * bj) = w; }
                }
        }
    }
};
struct EpiOut {
    static constexpr bool PERM = false, AFTER_DRAIN = false;
    const float* x; float* hout; bf16_t* hb; float* rowss;
    __device__ __forceinline__ void operator()(const f32x4 (&acc)[2][2][4][2], const Unit& u, int wr, int wc, int fr, int fq) const {
        const int row0 = u.pm * BM + wr * 64 + fr, col0 = u.pn * BM + wc * 32 + 4 * fq;
#pragma unroll
        for (int ai = 0; ai < 2; ++ai) {
            f32x4 pre[4][2][2];
#pragma unroll
            for (int m = 0; m < 4; ++m) { const size_t off = (size_t)(row0 + ai * HALF + m * 16) * 1024 + col0;
#pragma unroll
                for (int bj = 0; bj < 2; ++bj)
#pragma unroll
                    for (int n = 0; n < 2; ++n) pre[m][bj][n] = *(const f32x4*)(x + off + bj * HALF + n * 16); }
            asm volatile("" ::: "memory");
#pragma unroll
            for (int m = 0; m < 4; ++m) { const int row = row0 + ai * HALF + m * 16; const size_t off = (size_t)row * 1024 + col0; float ss = 0.f;
#pragma unroll
                for (int bj = 0; bj < 2; ++bj)
#pragma unroll
                    for (int n = 0; n < 2; ++n) { const size_t o2 = off + bj * HALF + n * 16; const f32x4 hv = pre[m][bj][n] + acc[ai][bj][m][n];
                        ss += (hv[0] * hv[0] + hv[1] * hv[1]) + (hv[2] * hv[2] + hv[3] * hv[3]);
                        u32x2 w; w.x = cvtpk(hv[0], hv[1]); w.y = cvtpk(hv[2], hv[3]); *(u32x2*)(hb + o2) = w; }
                ss += __shfl_xor(ss, 16); ss += __shfl_xor(ss, 32);
                if (fq == 0) atomicAdd(rowss + row, ss);
            }
            asm volatile("" ::: "memory");
        }
    }
};
struct EpiSwiGLU {
    static constexpr bool PERM = true, AFTER_DRAIN = false;
    bf16_t* hid; const float* rowss;
    __device__ __forceinline__ void operator()(const f32x4 (&acc)[2][2][4][2], const Unit& u, int wr, int wc, int fr, int fq) const {
        const int row0 = u.pm * BM + wr * 64 + fr, col0 = u.pn * 128 + wc * 32 + 8 * fq;
        float rs[2][4];
#pragma unroll
        for (int ai = 0; ai < 2; ++ai)
#pragma unroll
            for (int m = 0; m < 4; ++m) rs[ai][m] = rowss[row0 + ai * HALF + m * 16];
        asm volatile("" ::: "memory");
#pragma unroll
        for (int ai = 0; ai < 2; ++ai)
#pragma unroll
            for (int m = 0; m < 4; ++m) { const int row = row0 + ai * HALF + m * 16; const float r = rsqrtf(rs[ai][m] * (1.0f / 1024.0f) + RMS_EPS);
                float hv[8];
#pragma unroll
                for (int n = 0; n < 2; ++n)
#pragma unroll
                    for (int e = 0; e < 4; ++e) { const float g = acc[ai][0][m][n][e] * r, uu = acc[ai][1][m][n][e] * r;
                        hv[4 * n + e] = g * __builtin_amdgcn_rcpf(1.0f + __builtin_amdgcn_exp2f(-g * LOG2E)) * uu; }
                u32x4 w; w.x = cvtpk(hv[0], hv[1]); w.y = cvtpk(hv[2], hv[3]); w.z = cvtpk(hv[4], hv[5]); w.w = cvtpk(hv[6], hv[7]);
                *(u32x4*)(hid + (size_t)row * 2816 + col0) = w; }
    }
};
struct EpiDown {
    static constexpr bool PERM = false, AFTER_DRAIN = false;
    float* out; const bf16_t* hb;
    __device__ __forceinline__ void operator()(const f32x4 (&acc)[2][2][4][2], const Unit& u, int wr, int wc, int fr, int fq) const {
        const int row0 = u.pm * BM + wr * 64 + fr, col0 = u.pn * BM + wc * 32 + 4 * fq;
#pragma unroll
        for (int ai = 0; ai < 2; ++ai) {
            u32x2 pre[4][2][2];
#pragma unroll
            for (int m = 0; m < 4; ++m) { const size_t off = (size_t)(row0 + ai * HALF + m * 16) * 1024 + col0;
#pragma unroll
                for (int bj = 0; bj < 2; ++bj)
#pragma unroll
                    for (int n = 0; n < 2; ++n) pre[m][bj][n] = *(const u32x2*)(hb + off + bj * HALF + n * 16); }
            asm volatile("" ::: "memory");
#pragma unroll
            for (int m = 0; m < 4; ++m) { const size_t off = (size_t)(row0 + ai * HALF + m * 16) * 1024 + col0;
#pragma unroll
                for (int bj = 0; bj < 2; ++bj)
#pragma unroll
                    for (int n = 0; n < 2; ++n) { const u32x2 hw = pre[m][bj][n];
                        const f32x4 hv = {__uint_as_float(hw.x << 16), __uint_as_float(hw.x & 0xffff0000u), __uint_as_float(hw.y << 16), __uint_as_float(hw.y & 0xffff0000u)};
                        *(f32x4*)(out + off + bj * HALF + n * 16) = hv + acc[ai][bj][m][n]; } }
            asm volatile("" ::: "memory");
        }
    }
};
template <class Epi, class Sched, bool ALIGN_EPI = false, bool SP2 = false>
__device__ __forceinline__ void gemm_phase(PG8_LAS unsigned char* lds, const Gemm g, const Sched& S, const Epi& E) {
    int tid_ = threadIdx.x; asm volatile("" : "+v"(tid_)); const int tid = tid_, wid = __builtin_amdgcn_readfirstlane(tid >> 6), lane = tid & 63, wr = wid >> 2, wc = wid & 3, fr = lane & 15, fq = lane >> 4;
    const int K = g.K, nt = K / BK;
    unsigned voffA[2], voffB[2];
#pragma unroll
    for (int i = 0; i < 2; ++i) { int R, C; stage_rc(tid * 16 + i * 8192, R, C); const int Rb = Epi::PERM ? ((R & ~31) + perm32(R & 31)) : R;
        voffA[i] = (unsigned)(R * K + C) * 2u; voffB[i] = (unsigned)(Rb * K + C) * 2u; }
    const size_t kstep = (size_t)(BK * 2);
    const size_t hstep = (size_t)HALF * K * 2;
    const size_t tstep = 2 * hstep;
    const unsigned ldsw = (unsigned)wid * 1024u;
    const int aoff = lds_byte(wr * 64 + fr, fq * 8), boff = lds_byte(wc * 32 + fr, fq * 8);
#define PG8_SA(b, h) (((b) * 2 + (h)) * HTB)
#define PG8_SB(b, h) ((4 + (b) * 2 + (h)) * HTB)
#define PG8_STAGE(bufoff, gbase, voff) do { _Pragma("unroll") for (int _i = 0; _i < 2; ++_i) \
        __builtin_amdgcn_global_load_lds((const unsigned*)((const char*)(gbase) + (voff)[_i]), (PG8_LAS unsigned*)(lds + (bufoff) + ldsw + _i * 8192), 16, 0, 0); } while (0)
#define PG8_LDA(dst, b, h) do { _Pragma("unroll") for (int m = 0; m < 4; ++m) _Pragma("unroll") for (int k = 0; k < 2; ++k) dst[m][k] = *(const PG8_LAS bf16x8*)(lds + PG8_SA(b, h) + aoff + m * 2048 + k * 1024); } while (0)
#define PG8_LDB(dst, b, h) do { _Pragma("unroll") for (int n = 0; n < 2; ++n) _Pragma("unroll") for (int k = 0; k < 2; ++k) dst[n][k] = *(const PG8_LAS bf16x8*)(lds + PG8_SB(b, h) + boff + n * 2048 + k * 1024); } while (0)
#define PG8_MMA(ai, bj, At, Bt) do { __builtin_amdgcn_s_setprio(1); _Pragma("unroll") for (int m = 0; m < 4; ++m) _Pragma("unroll") for (int n = 0; n < 2; ++n) _Pragma("unroll") for (int k = 0; k < 2; ++k) \
        acc[ai][bj][m][n] = __builtin_amdgcn_mfma_f32_16x16x32_bf16(Bt[n][k], At[m][k], acc[ai][bj][m][n], 0, 0, 0); __builtin_amdgcn_s_setprio(0); } while (0)
#define PG8_WAIT_V(n) asm volatile("s_waitcnt vmcnt(" #n ")" ::: "memory")
#define PG8_WAIT_L(n) asm volatile("s_waitcnt lgkmcnt(" #n ")" ::: "memory")
#define PG8_BAR __builtin_amdgcn_s_barrier()
#define PG8_SCHED __builtin_amdgcn_sched_barrier(0)
    Unit cur, nxt; int ui = 0;
    if (!S.next(0, cur)) return;
    f32x4 acc[2][2][4][2];
#pragma unroll
    for (int a = 0; a < 2; ++a)
#pragma unroll
        for (int b = 0; b < 2; ++b)
#pragma unroll
            for (int m = 0; m < 4; ++m)
#pragma unroll
                for (int n = 0; n < 2; ++n) acc[a][b][m][n] = (f32x4){0.f, 0.f, 0.f, 0.f};
    bf16x8 At[4][2], B0[2][2], B1[2][2];
    const char* cA = (const char*)g.A + (size_t)cur.pm * tstep; const char* cB = (const char*)g.Bt + (size_t)cur.pn * tstep;
    S.a_ready(cur);
    if constexpr (SP2) {
        PG8_STAGE(PG8_SB(0, 0), cB, voffB); PG8_STAGE(PG8_SB(0, 1), cB + hstep, voffB); PG8_STAGE(PG8_SA(0, 0), cA, voffA); PG8_STAGE(PG8_SA(0, 1), cA + hstep, voffA);
        if (wr == 1) PG8_BAR;
        PG8_WAIT_V(2); PG8_BAR;
        PG8_STAGE(PG8_SB(1, 0), cB + kstep, voffB); PG8_STAGE(PG8_SA(1, 0), cA + kstep, voffA); PG8_STAGE(PG8_SB(1, 1), cB + hstep + kstep, voffB);
        PG8_WAIT_V(6); PG8_BAR;
    } else {
        PG8_STAGE(PG8_SB(0, 0), cB, voffB); PG8_STAGE(PG8_SA(0, 0), cA, voffA); PG8_STAGE(PG8_SB(0, 1), cB + hstep, voffB); PG8_STAGE(PG8_SA(0, 1), cA + hstep, voffA);
        if (wr == 1) PG8_BAR;
        PG8_WAIT_V(4); PG8_BAR;
        PG8_STAGE(PG8_SB(1, 0), cB + kstep, voffB); PG8_STAGE(PG8_SA(1, 0), cA + kstep, voffA); PG8_STAGE(PG8_SB(1, 1), cB + hstep + kstep, voffB);
        PG8_WAIT_V(6); PG8_BAR;
    }
    for (;;) {
        const bool has_next = S.next(ui + 1, nxt);
        const char* nA = has_next ? (const char*)g.A + (size_t)nxt.pm * tstep : cA; const char* nB = has_next ? (const char*)g.Bt + (size_t)nxt.pn * tstep : cB;
        for (int t = 0; t < nt; t += 2) {
            const bool last = (t == nt - 2);
            const char* a1 = cA + (size_t)(t + 1) * kstep;
            const char* a2 = last ? nA : cA + (size_t)(t + 2) * kstep; const char* b2 = last ? nB : cB + (size_t)(t + 2) * kstep;
            const char* a3 = a2 + kstep; const char* b3 = b2 + kstep;
            if (last && has_next) S.a_ready(nxt);
            if constexpr (SP2) {
            PG8_LDB(B0, 0, 0); PG8_LDB(B1, 0, 1); PG8_SCHED; PG8_LDA(At, 0, 0); PG8_STAGE(PG8_SA(1, 1), a1 + hstep, voffA);
            PG8_WAIT_V(8); PG8_WAIT_L(0); PG8_BAR; PG8_MMA(0, 0, At, B0); PG8_MMA(0, 1, At, B1); PG8_BAR; PG8_SCHED;
            PG8_LDA(At, 0, 1); PG8_STAGE(PG8_SB(0, 0), b2, voffB); PG8_STAGE(PG8_SB(0, 1), b2 + hstep, voffB); PG8_STAGE(PG8_SA(0, 0), a2, voffA);
            PG8_WAIT_V(8); PG8_WAIT_L(0); PG8_BAR; PG8_MMA(1, 0, At, B0); PG8_MMA(1, 1, At, B1); PG8_BAR; PG8_SCHED;
            PG8_LDB(B0, 1, 0); PG8_LDB(B1, 1, 1); PG8_SCHED; PG8_LDA(At, 1, 0); PG8_STAGE(PG8_SA(0, 1), a2 + hstep, voffA);
            PG8_WAIT_V(8); PG8_WAIT_L(0); PG8_BAR; PG8_MMA(0, 0, At, B0); PG8_MMA(0, 1, At, B1); PG8_BAR; PG8_SCHED;
            PG8_LDA(At, 1, 1); PG8_STAGE(PG8_SB(1, 0), b3, voffB); PG8_STAGE(PG8_SB(1, 1), b3 + hstep, voffB); PG8_STAGE(PG8_SA(1, 0), a3, voffA);
            PG8_WAIT_V(8); PG8_WAIT_L(0); PG8_BAR; PG8_MMA(1, 0, At, B0); PG8_MMA(1, 1, At, B1); PG8_BAR; PG8_SCHED;
            } else {
            PG8_LDB(B0, 0, 0); PG8_SCHED; PG8_LDA(At, 0, 0); PG8_STAGE(PG8_SA(1, 1), a1 + hstep, voffA);
            PG8_WAIT_L(8); PG8_BAR; PG8_WAIT_L(0); PG8_MMA(0, 0, At, B0); PG8_BAR; PG8_SCHED;
            PG8_LDB(B1, 0, 1); PG8_STAGE(PG8_SB(0, 0), b2, voffB);
            PG8_BAR; PG8_WAIT_L(0); PG8_MMA(0, 1, At, B1); PG8_BAR;
            PG8_LDA(At, 0, 1); PG8_STAGE(PG8_SA(0, 0), a2, voffA);
            PG8_BAR; PG8_WAIT_L(0); PG8_MMA(1, 0, At, B0); PG8_BAR; PG8_SCHED;
            PG8_STAGE(PG8_SB(0, 1), b2 + hstep, voffB);
            PG8_WAIT_V(6); PG8_BAR; PG8_MMA(1, 1, At, B1); PG8_BAR;
            PG8_LDB(B0, 1, 0); PG8_SCHED; PG8_LDA(At, 1, 0); PG8_STAGE(PG8_SA(0, 1), a2 + hstep, voffA);
            PG8_WAIT_L(8); PG8_BAR; PG8_WAIT_L(0); PG8_MMA(0, 0, At, B0); PG8_BAR; PG8_SCHED;
            PG8_LDB(B1, 1, 1); PG8_STAGE(PG8_SB(1, 0), b3, voffB);
            PG8_BAR; PG8_WAIT_L(0); PG8_MMA(0, 1, At, B1); PG8_BAR;
            PG8_LDA(At, 1, 1); PG8_STAGE(PG8_SA(1, 0), a3, voffA);
            PG8_BAR; PG8_WAIT_L(0); PG8_MMA(1, 0, At, B0); PG8_BAR; PG8_SCHED;
            PG8_STAGE(PG8_SB(1, 1), b3 + hstep, voffB);
            PG8_WAIT_V(6); PG8_BAR; PG8_MMA(1, 1, At, B1); PG8_BAR;
            }
        }
        if constexpr (ALIGN_EPI) { if (wr == 0) PG8_BAR; }
        if constexpr (!Epi::AFTER_DRAIN) { E(acc, cur, wr, wc, fr, fq); S.done(cur); }
        if (!has_next) break;
#pragma unroll
        for (int a = 0; a < 2; ++a)
#pragma unroll
            for (int b = 0; b < 2; ++b)
#pragma unroll
                for (int m = 0; m < 4; ++m)
#pragma unroll
                    for (int n = 0; n < 2; ++n) acc[a][b][m][n] = (f32x4){0.f, 0.f, 0.f, 0.f};
        cur = nxt; cA = nA; cB = nB; ++ui;
        if constexpr (ALIGN_EPI) { if (wr == 1) PG8_BAR; }
    }
    PG8_WAIT_V(0);
    if constexpr (!ALIGN_EPI) { if (wr == 0) PG8_BAR; }
    PG8_BAR;
    if constexpr (Epi::AFTER_DRAIN) { E.fused(acc, cur, wr, wc, fr, fq, lds, wid, lane); S.done(cur); }
#undef PG8_SA
#undef PG8_SB
#undef PG8_STAGE
#undef PG8_LDA
#undef PG8_LDB
#undef PG8_MMA
#undef PG8_WAIT_V
#undef PG8_WAIT_L
#undef PG8_BAR
#undef PG8_SCHED
}
}
using pg8::bf16_t; using pg8::bf16x8; using pg8::f32x4; using pg8::u32x4; using pg8::u32x2; using pg8::cvtpk; using pg8::RMS_EPS; using pg8::LOG2E;
typedef float f32x16 __attribute__((ext_vector_type(16)));
#define LAS __attribute__((address_space(3)))
constexpr int NTHR = 512, NWAVES = 8;
constexpr int BATCH = 2, SEQ = 8192, DM = 1024, M = BATCH * SEQ, DFF = 2816, INW = 3088;
constexpr size_t MiB = 1u << 20;
constexpr size_t WS_BAR = 0;
constexpr size_t WS_QHEAD = 15360;
constexpr size_t WS_ROWSS = 64 * 1024;
constexpr size_t WS_WIN = 2 * MiB;
constexpr size_t WS_WO = 8 * MiB;
constexpr size_t WS_WGU = 10 * MiB;
constexpr size_t WS_WD = 21 * MiB;
constexpr size_t WS_GLR = 27 * MiB;
constexpr size_t WS_DVEC = 28 * MiB;
constexpr size_t WS_XN = 32 * MiB;
constexpr size_t WS_PROJ = 64 * MiB;
constexpr size_t WS_VT = 160 * MiB;
constexpr size_t WS_GVT = 176 * MiB;
constexpr size_t WS_MIX = 192 * MiB;
constexpr size_t WS_ST = 224 * MiB;
constexpr size_t WS_END = 256 * MiB;
constexpr int LDS_BYTES = 147456;

__device__ __forceinline__ float bf2f(bf16_t v) { return __uint_as_float((unsigned)v << 16); }
__device__ __forceinline__ bf16_t f2bf(float f) { return (bf16_t)(cvtpk(f, f) & 0xffffu); }
__device__ __forceinline__ float wave_sum(float v) {
#pragma unroll
    for (int o = 1; o < 64; o <<= 1) v += __shfl_xor(v, o);
    return v;
}
__device__ __forceinline__ float wave_max(float v) {
#pragma unroll
    for (int o = 1; o < 64; o <<= 1) v = fmaxf(v, __shfl_xor(v, o));
    return v;
}
__device__ __forceinline__ int crow(int r, int hi) { return (r & 3) + 8 * (r >> 2) + 4 * hi; }
__device__ __forceinline__ int pi_row(int m) { return (m & ~12) | ((m & 4) << 1) | ((m & 8) >> 1); }
__device__ __forceinline__ bf16x8 pack8(float a0, float a1, float a2, float a3, float a4, float a5, float a6, float a7) {
    u32x4 w; w.x = cvtpk(a0, a1); w.y = cvtpk(a2, a3); w.z = cvtpk(a4, a5); w.w = cvtpk(a6, a7); return __builtin_bit_cast(bf16x8, w);
}

template <int MODE> __device__ __forceinline__ int wrow(int n) {
    if (MODE == 1) { const int pn = n >> 8, L = n & 255; return pn * 256 + ((L >> 5) & 1) * 128 + (L >> 6) * 32 + (L & 31); }
    if (MODE == 2) return (n >> 7) * 256 + (n & 127);
    if (MODE == 3) return (n >> 7) * 256 + 128 + (n & 127);
    return n;
}
template <int MODE> __device__ __forceinline__ void p0_transpose_item(const float* W, int ld, int K, int ncols, bf16_t* WT, const float* gain, LAS float* scr, int item, int lane) {
    const int nblk = ncols / 32, kb = item / nblk, nb = item % nblk, k0 = 64 * kb, n0 = 32 * nb;
    float tv[32];
#pragma unroll
    for (int i = 0; i < 32; ++i) { const int kk = 2 * i + (lane >> 5); tv[i] = W[(size_t)(k0 + kk) * ld + n0 + (lane & 31)]; }
    if (gain) {
#pragma unroll
        for (int i = 0; i < 32; ++i) tv[i] *= gain[k0 + 2 * i + (lane >> 5)];
    }
#pragma unroll
    for (int i = 0; i < 32; ++i) scr[(2 * i + (lane >> 5)) * 33 + (lane & 31)] = tv[i];
    asm volatile("s_waitcnt lgkmcnt(0)" ::: "memory");
    const int c = lane & 7;
#pragma unroll
    for (int j = 0; j < 4; ++j) { const int n = (lane >> 3) + 8 * j; const LAS float* s = scr + (8 * c) * 33 + n;
        u32x4 o; o.x = cvtpk(s[0 * 33], s[1 * 33]); o.y = cvtpk(s[2 * 33], s[3 * 33]); o.z = cvtpk(s[4 * 33], s[5 * 33]); o.w = cvtpk(s[6 * 33], s[7 * 33]);
        *(u32x4*)(WT + (size_t)wrow<MODE>(n0 + n) * K + k0 + 8 * c) = o; }
    asm volatile("s_waitcnt lgkmcnt(0)" ::: "memory");
}
struct P0Args { const float *x, *again, *w_in, *w_out, *fgain, *w_g, *w_u, *w_d; bf16_t *WinT, *WoT, *WguT, *WdT, *XN; float *glr, *rowss; };
__device__ __forceinline__ void p0_prologue(LAS unsigned char* lds, const P0Args& A, int G, int bid) {
    int tid_ = threadIdx.x; asm volatile("" : "+v"(tid_)); const int tid = tid_, lane = tid & 63, wave = __builtin_amdgcn_readfirstlane(tid >> 6);
    LAS float* scr = (LAS float*)(lds + wave * 16384);
    const int gw = bid * NWAVES + wave, NGW = G * NWAVES;
    for (int i = bid * NTHR + tid; i < M; i += G * NTHR) A.rowss[i] = 0.f;
    for (int it = gw; it < 16 * 96; it += NGW) p0_transpose_item<1>(A.w_in, INW, 1024, 3072, A.WinT, nullptr, scr, it, lane);
    __syncthreads();
    LAS float* WtT = (LAS float*)lds;
    { float wv[32];
#pragma unroll
      for (int q = 0; q < 32; ++q) { const int i = tid + NTHR * q; wv[q] = A.w_in[(size_t)(i >> 4) * INW + 3072 + (i & 15)]; }
#pragma unroll
      for (int q = 0; q < 32; ++q) { const int i = tid + NTHR * q; WtT[(i & 15) * 1024 + (i >> 4)] = wv[q]; } }
    __syncthreads();
    f32x4 gnv[4];
#pragma unroll
    for (int j = 0; j < 4; ++j) gnv[j] = ((const f32x4*)A.again)[64 * j + lane];
    for (int m = gw; m < M; m += NGW) {
        const f32x4* xr = (const f32x4*)(A.x + (size_t)m * 1024) + lane;
        f32x4 v[4]; float ss = 0.f;
#pragma unroll
        for (int j = 0; j < 4; ++j) { v[j] = xr[64 * j]; ss += (v[j][0] * v[j][0] + v[j][1] * v[j][1]) + (v[j][2] * v[j][2] + v[j][3] * v[j][3]); }
        const float rstd = rsqrtf(wave_sum(ss) * (1.0f / 1024.0f) + RMS_EPS);
        unsigned long long* o8 = (unsigned long long*)(A.XN + (size_t)m * 1024) + lane;
#pragma unroll
        for (int j = 0; j < 4; ++j) { const f32x4 g = gnv[j]; v[j] = v[j] * rstd * g;
            o8[64 * j] = (unsigned long long)cvtpk(v[j][0], v[j][1]) | ((unsigned long long)cvtpk(v[j][2], v[j][3]) << 32); }
        float p[16];
#pragma unroll
        for (int r = 0; r < 16; ++r) { float a = 0.f;
#pragma unroll
            for (int j = 0; j < 4; ++j) { const f32x4 w = *(const LAS f32x4*)(WtT + r * 1024 + 256 * j + 4 * lane); a += (v[j][0] * w[0] + v[j][1] * w[1]) + (v[j][2] * w[2] + v[j][3] * w[3]); }
            p[r] = a; if (r & 1) asm volatile("" ::: "memory"); }
#pragma unroll
        for (int i = 0; i < 8; ++i) { const bool up = lane & 1; const float send = up ? p[i] : p[i + 8], keep = up ? p[i + 8] : p[i]; p[i] = keep + __shfl_xor(send, 1); }
#pragma unroll
        for (int i = 0; i < 4; ++i) { const bool up = lane & 2; const float send = up ? p[i] : p[i + 4], keep = up ? p[i + 4] : p[i]; p[i] = keep + __shfl_xor(send, 2); }
#pragma unroll
        for (int i = 0; i < 2; ++i) { const bool up = lane & 4; const float send = up ? p[i] : p[i + 2], keep = up ? p[i + 2] : p[i]; p[i] = keep + __shfl_xor(send, 4); }
        { const bool up = lane & 8; const float send = up ? p[0] : p[1], keep = up ? p[1] : p[0]; p[0] = keep + __shfl_xor(send, 8); }
        p[0] += __shfl_xor(p[0], 16); p[0] += __shfl_xor(p[0], 32);
        if (lane < 16) { const int r = 8 * (lane & 1) + 4 * ((lane >> 1) & 1) + 2 * ((lane >> 2) & 1) + ((lane >> 3) & 1); A.glr[(size_t)m * 16 + r] = p[0]; }
    }
}

constexpr int LW_O = 16 * 32, LW_G = 16 * 88, LW_D = 44 * 32, LW_ITEMS = LW_O + 2 * LW_G + LW_D, LW_BLOCK_ITEMS = LW_ITEMS / 8;
static_assert(LW_ITEMS % 8 == 0, "late-weight pieces come in groups of eight");
__device__ __forceinline__ void late_weights_item(LAS unsigned char* lds, const P0Args& A, int bi) {
    int tid_ = threadIdx.x; asm volatile("" : "+v"(tid_)); const int lane = tid_ & 63, wave = __builtin_amdgcn_readfirstlane(tid_ >> 6);
    LAS float* scr = (LAS float*)(lds + wave * 16384);
    int r = bi * 8 + wave;
    if (r < LW_O) { p0_transpose_item<0>(A.w_out, 1024, 1024, 1024, A.WoT, nullptr, scr, r, lane); return; } r -= LW_O;
    if (r < LW_G) { p0_transpose_item<2>(A.w_g, DFF, 1024, DFF, A.WguT, A.fgain, scr, r, lane); return; } r -= LW_G;
    if (r < LW_G) { p0_transpose_item<3>(A.w_u, DFF, 1024, DFF, A.WguT, A.fgain, scr, r, lane); return; } r -= LW_G;
    p0_transpose_item<0>(A.w_d, 1024, DFF, 1024, A.WdT, nullptr, scr, r, lane);
}
constexpr int RS = 144;
constexpr int G1_GLR = 0, G1_TOT = 4096, G1_QT = 6144, G1_KT = G1_QT + 64 * RS, G1_KD = G1_KT + 64 * RS, G1_VT = G1_KD + 64 * RS;
struct GlaArgs { const bf16_t* proj; const bf16_t* gvt; const float* glr; const float* w_up; const float* b_gate; bf16_t* QT; float* OINTRA; float* ST; float* dvec; };
__device__ __forceinline__ void gla_chunk_load(const GlaArgs& A, int task, int tid, int lane, int wid, float (&g)[2], u32x4 (&v)[2], unsigned (&qv)[8], unsigned (&kv)[8]) {
    const int bh = task >> 7, c = task & 127, b = bh >> 2, h = bh & 3; const int tok0 = b * SEQ + c * 64;
#pragma unroll
    for (int i = 0; i < 2; ++i) g[i] = A.glr[(size_t)tok0 * 16 + tid + NTHR * i];
#pragma unroll
    for (int i = 0; i < 2; ++i) { const int idx = tid + NTHR * i, row = idx >> 3, ch = idx & 7; v[i] = *(const u32x4*)(A.gvt + ((size_t)(bh * 128 + row)) * SEQ + c * 64 + ch * 8); }
#pragma unroll
    for (int i = 0; i < 8; ++i) { const bf16_t* p = A.proj + (size_t)(tok0 + 8 * wid + i) * 3072 + 1536 + h * 64 + lane; qv[i] = (unsigned)p[0]; kv[i] = (unsigned)p[256]; }
}
__device__ __forceinline__ void gla_chunk_body(LAS unsigned char* lds, const GlaArgs& A, int task, int tid, int lane, int wid, const float (&g)[2], const u32x4 (&v)[2], const unsigned (&qr)[8], const unsigned (&kr)[8], const float (&wup)[16], float bias) {
    const int r32 = lane & 31, hi = lane >> 5;
    LAS float* glrS = (LAS float*)(lds + G1_GLR); LAS float* tot = (LAS float*)(lds + G1_TOT);
    {
#pragma unroll
        for (int i = 0; i < 2; ++i) glrS[tid + NTHR * i] = g[i];
#pragma unroll
        for (int i = 0; i < 2; ++i) { const int idx = tid + NTHR * i, row = idx >> 3, ch = idx & 7; *(LAS u32x4*)(lds + G1_VT + row * RS + ch * 16) = v[i]; }
        __syncthreads();
        float cum[8]; float run = 0.f;
#pragma unroll
        for (int i = 0; i < 8; ++i) { const int t = 8 * wid + i; float z = bias;
#pragma unroll
            for (int r = 0; r < 16; ++r) z += glrS[t * 16 + r] * wup[r];
            const float y = -z; const float sp = fmaxf(y, 0.f) + log1pf(__expf(-fabsf(y)));
            run -= sp * (1.0f / 16.0f); cum[i] = run; }
        tot[wid * 64 + lane] = run;
        __syncthreads();
        float prefix = 0.f, total = 0.f;
#pragma unroll
        for (int w = 0; w < 8; ++w) { const float tv = tot[w * 64 + lane]; total += tv; if (w < wid) prefix += tv; }
        float kd[8];
#pragma unroll
        for (int i = 0; i < 8; ++i) { const int t = 8 * wid + i; const float bb = prefix + cum[i]; const float qvi = __uint_as_float(qr[i] << 16), kvi = __uint_as_float(kr[i] << 16);
            const bf16_t qt = f2bf(qvi * __expf(bb)), kt = f2bf(kvi * __expf(-bb)); kd[i] = kvi * __expf(total - bb);
            *(LAS bf16_t*)(lds + G1_QT + t * RS + lane * 2) = qt; *(LAS bf16_t*)(lds + G1_KT + t * RS + lane * 2) = kt;
            A.QT[(size_t)task * 4096 + t * 64 + lane] = qt; }
        *(LAS bf16x8*)(lds + G1_KD + lane * RS + wid * 16) = pack8(kd[0], kd[1], kd[2], kd[3], kd[4], kd[5], kd[6], kd[7]);
        if (wid == 0) A.dvec[task * 64 + lane] = __expf(total);
        __syncthreads();
        const int tb = wid & 1, vb = wid >> 1;
        f32x16 o = {};
#pragma unroll
        for (int sb = 0; sb < 2; ++sb) {
            if (sb <= tb) {
                f32x16 X = {};
#pragma unroll
                for (int ks = 0; ks < 4; ++ks) {
                    const bf16x8 a = *(const LAS bf16x8*)(lds + G1_KT + (32 * sb + pi_row(r32)) * RS + (16 * ks + 8 * hi) * 2);
                    const bf16x8 bq = *(const LAS bf16x8*)(lds + G1_QT + (32 * tb + r32) * RS + (16 * ks + 8 * hi) * 2);
                    X = __builtin_amdgcn_mfma_f32_32x32x16_bf16(a, bq, X, 0, 0, 0);
                }
                if (sb == tb) {
#pragma unroll
                    for (int r = 0; r < 16; ++r) { if ((16 * (r >> 3) + (r & 7)) > r32 - 8 * hi) X[r] = 0.f; }
                }
                const bf16x8 P0 = pack8(X[0], X[1], X[2], X[3], X[4], X[5], X[6], X[7]), P1 = pack8(X[8], X[9], X[10], X[11], X[12], X[13], X[14], X[15]);
                const bf16x8 v0 = *(const LAS bf16x8*)(lds + G1_VT + (32 * vb + r32) * RS + (32 * sb + 8 * hi) * 2);
                const bf16x8 v1 = *(const LAS bf16x8*)(lds + G1_VT + (32 * vb + r32) * RS + (32 * sb + 16 + 8 * hi) * 2);
                o = __builtin_amdgcn_mfma_f32_32x32x16_bf16(P0, v0, o, 0, 0, 0);
                o = __builtin_amdgcn_mfma_f32_32x32x16_bf16(P1, v1, o, 0, 0, 0);
            }
        }
        u32x4* op = (u32x4*)((unsigned*)A.OINTRA + (size_t)task * 4096 + (tb * 4 + vb) * 512 + lane * 8);
#pragma unroll
        for (int q4 = 0; q4 < 2; ++q4) { u32x4 w; w.x = cvtpk(o[8 * q4], o[8 * q4 + 1]); w.y = cvtpk(o[8 * q4 + 2], o[8 * q4 + 3]); w.z = cvtpk(o[8 * q4 + 4], o[8 * q4 + 5]); w.w = cvtpk(o[8 * q4 + 6], o[8 * q4 + 7]); op[q4] = w; }
        f32x16 ut = {};
#pragma unroll
        for (int ks = 0; ks < 4; ++ks) {
            const bf16x8 a = *(const LAS bf16x8*)(lds + G1_VT + (32 * vb + r32) * RS + (16 * ks + 8 * hi) * 2);
            const bf16x8 bk = *(const LAS bf16x8*)(lds + G1_KD + (32 * tb + r32) * RS + (16 * ks + 8 * hi) * 2);
            ut = __builtin_amdgcn_mfma_f32_32x32x16_bf16(a, bk, ut, 0, 0, 0);
        }
        float* sp = A.ST + (size_t)task * 8192 + 32 * tb + r32;
#pragma unroll
        for (int r = 0; r < 16; ++r) sp[(32 * vb + crow(r, hi)) * 64] = ut[r];
        __syncthreads();
    }
}
__device__ __forceinline__ void gla_chunk_quad(LAS unsigned char* lds, const GlaArgs& A, int task0) {
    int tid_ = threadIdx.x; asm volatile("" : "+v"(tid_)); const int tid = tid_, lane = tid & 63, wid = __builtin_amdgcn_readfirstlane(tid >> 6);
    const int h = (task0 >> 7) & 3;
    float gA[2], gB[2], gC[2], gD[2]; u32x4 vA[2], vB[2], vC[2], vD[2]; unsigned qA[8], kA[8], qB[8], kB[8], qC[8], kC[8], qD[8], kD[8];
    gla_chunk_load(A, task0, tid, lane, wid, gA, vA, qA, kA);
    gla_chunk_load(A, task0 + 1, tid, lane, wid, gB, vB, qB, kB);
    gla_chunk_load(A, task0 + 2, tid, lane, wid, gC, vC, qC, kC);
    gla_chunk_load(A, task0 + 3, tid, lane, wid, gD, vD, qD, kD);
    float wup[16];
#pragma unroll
    for (int r = 0; r < 16; ++r) wup[r] = A.w_up[r * 256 + h * 64 + lane];
    const float bias = A.b_gate[h * 64 + lane];
    gla_chunk_body(lds, A, task0, tid, lane, wid, gA, vA, qA, kA, wup, bias);
    gla_chunk_body(lds, A, task0 + 1, tid, lane, wid, gB, vB, qB, kB, wup, bias);
    gla_chunk_body(lds, A, task0 + 2, tid, lane, wid, gC, vC, qC, kC, wup, bias);
    gla_chunk_body(lds, A, task0 + 3, tid, lane, wid, gD, vD, qD, kD, wup, bias);
}
__device__ __forceinline__ void gla_scan_phase(float* ST, const float* dvec, int G, int bid) {
    int tid_ = threadIdx.x; asm volatile("" : "+v"(tid_));
    for (int gid = bid * NTHR + tid_; gid < 65536; gid += G * NTHR) {
        const int bh = gid >> 13, e = gid & 8191, k = e & 63;
        float* sp = ST + (size_t)bh * 128 * 8192 + e; const float* dp = dvec + bh * 128 * 64 + k;
        float S = 0.f;
        for (int c0 = 0; c0 < 128; c0 += 32) {
            float u[32], d[32];
#pragma unroll
            for (int j = 0; j < 32; ++j) { u[j] = sp[(size_t)(c0 + j) * 8192]; d[j] = dp[(c0 + j) * 64]; }
#pragma unroll
            for (int j = 0; j < 32; ++j) { sp[(size_t)(c0 + j) * 8192] = S; S = d[j] * S + u[j]; }
        }
    }
}
__device__ __forceinline__ void gla_scan_item(const float* ST, bf16_t* SB, const float* dvec, int j) {
    int tid_ = threadIdx.x; asm volatile("" : "+v"(tid_));
    {
        const int bh = j >> 4, e = (j & 15) * NTHR + tid_, k = e & 63;
        const float* sp = ST + (size_t)bh * 128 * 8192 + e; bf16_t* so = SB + (size_t)bh * 128 * 8192 + e; const float* dp = dvec + bh * 128 * 64 + k;
        float S = 0.f;
        for (int c0 = 0; c0 < 128; c0 += 32) {
            float u[32], d[32];
#pragma unroll
            for (int jj = 0; jj < 32; ++jj) { u[jj] = sp[(size_t)(c0 + jj) * 8192]; d[jj] = dp[(c0 + jj) * 64]; }
#pragma unroll
            for (int jj = 0; jj < 32; ++jj) { so[(size_t)(c0 + jj) * 8192] = f2bf(S); S = d[jj] * S + u[jj]; }
        }
    }
}
__device__ __forceinline__ void item_done(unsigned* cnt) {
    if (cnt != nullptr) asm volatile("s_waitcnt vmcnt(0)" ::: "memory");
    __builtin_amdgcn_s_barrier();
    if (threadIdx.x == 0 && cnt != nullptr) { __builtin_amdgcn_fence(__ATOMIC_RELEASE, "agent"); asm volatile("s_waitcnt vmcnt(0)" ::: "memory"); __hip_atomic_fetch_add(cnt, 1u, __ATOMIC_RELAXED, __HIP_MEMORY_SCOPE_AGENT); }
}
__device__ __forceinline__ void item_wait(unsigned* cnt, unsigned want) {
    if (threadIdx.x == 0 && cnt != nullptr) { unsigned spn = 0; while (__hip_atomic_load(cnt, __ATOMIC_RELAXED, __HIP_MEMORY_SCOPE_AGENT) < want) { __builtin_amdgcn_s_sleep(2); if (++spn > (1u << 16)) break; }
        __builtin_amdgcn_fence(__ATOMIC_ACQUIRE, "agent"); asm volatile("s_waitcnt vmcnt(0)" ::: "memory"); }
    __syncthreads();
}
struct Gla3Args { const bf16_t* proj; const bf16_t* QT; const float* OINTRA; const bf16_t* SB; const float* ggain; bf16_t* mixed; };
__device__ __forceinline__ void gla_out_task(const Gla3Args& A, int wt) {
    int tid_ = threadIdx.x; asm volatile("" : "+v"(tid_)); const int tid = tid_, lane = tid & 63, r32 = lane & 31, hi = lane >> 5;
    {
        const int task = wt >> 1, tb = wt & 1, bh = task >> 7, c = task & 127, b = bh >> 2, h = bh & 3; const int tok0 = b * SEQ + c * 64 + 32 * tb;
        const bf16_t* grow = A.proj + (size_t)tok0 * 3072 + 2560 + h * 128; bf16_t* mrow = A.mixed + (size_t)tok0 * 1024 + 512 + h * 128;
        unsigned goff = (unsigned)(4 * hi * 3072 + r32), moff = (unsigned)(4 * hi * 1024 + r32); asm volatile("" : "+v"(goff), "+v"(moff));
        float ggv[4];
#pragma unroll
        for (int vb = 0; vb < 4; ++vb) ggv[vb] = A.ggain[32 * vb + r32];
        bf16x8 qa[4];
#pragma unroll
        for (int ks = 0; ks < 4; ++ks) qa[ks] = *(const bf16x8*)(A.QT + (size_t)task * 4096 + (32 * tb + r32) * 64 + 16 * ks + 8 * hi);
        f32x16 acc[4];
        bf16x8 sfA[4];
#define G3_SLOAD(DST, VB) do { _Pragma("unroll") for (int ks_ = 0; ks_ < 4; ++ks_) DST[ks_] = *(const bf16x8*)(A.SB + (size_t)task * 8192 + (32 * (VB) + r32) * 64 + 16 * ks_ + 8 * hi); } while (0)
#define G3_MMA(SRC, VB) do { _Pragma("unroll") for (int ks_ = 0; ks_ < 4; ++ks_) acc[VB] = __builtin_amdgcn_mfma_f32_32x32x16_bf16(qa[ks_], SRC[ks_], acc[VB], 0, 0, 0); } while (0)
#pragma unroll
        for (int vb = 0; vb < 4; ++vb) {
            const u32x4* op = (const u32x4*)((const unsigned*)A.OINTRA + (size_t)task * 4096 + (tb * 4 + vb) * 512 + lane * 8);
#pragma unroll
            for (int q4 = 0; q4 < 2; ++q4) { const u32x4 t4 = op[q4];
                acc[vb][8 * q4] = __uint_as_float(t4.x << 16); acc[vb][8 * q4 + 1] = __uint_as_float(t4.x & 0xffff0000u); acc[vb][8 * q4 + 2] = __uint_as_float(t4.y << 16); acc[vb][8 * q4 + 3] = __uint_as_float(t4.y & 0xffff0000u);
                acc[vb][8 * q4 + 4] = __uint_as_float(t4.z << 16); acc[vb][8 * q4 + 5] = __uint_as_float(t4.z & 0xffff0000u); acc[vb][8 * q4 + 6] = __uint_as_float(t4.w << 16); acc[vb][8 * q4 + 7] = __uint_as_float(t4.w & 0xffff0000u); }
        }
#pragma unroll
        for (int vb = 0; vb < 4; ++vb) { G3_SLOAD(sfA, vb); __builtin_amdgcn_sched_barrier(0); G3_MMA(sfA, vb); __builtin_amdgcn_sched_barrier(0); }
#undef G3_SLOAD
#undef G3_MMA
        bf16_t gt[4][16];
#pragma unroll
        for (int vb = 0; vb < 4; ++vb)
#pragma unroll
            for (int r = 0; r < 16; ++r) gt[vb][r] = grow[goff + (unsigned)(((r & 3) + 8 * (r >> 2)) * 3072 + 32 * vb)];
        float rstd[16];
#pragma unroll
        for (int r = 0; r < 16; ++r) { float ss = 0.f;
#pragma unroll
            for (int vb = 0; vb < 4; ++vb) ss += acc[vb][r] * acc[vb][r];
            rstd[r] = ss; }
#pragma unroll
        for (int o = 1; o < 32; o <<= 1) {
#pragma unroll
            for (int r = 0; r < 16; ++r) rstd[r] += __shfl_xor(rstd[r], o);
            __builtin_amdgcn_sched_barrier(0); }
#pragma unroll
        for (int r = 0; r < 16; ++r) rstd[r] = rsqrtf(rstd[r] * (1.0f / 128.0f) + RMS_EPS);
#pragma unroll
        for (int vb = 0; vb < 4; ++vb) { const float gg = ggv[vb];
#pragma unroll
            for (int r = 0; r < 16; ++r) { const int rr = (r & 3) + 8 * (r >> 2);
                const float gate = bf2f(gt[vb][r]);
                const float sg = gate * __builtin_amdgcn_rcpf(1.0f + __builtin_amdgcn_exp2f(-gate * LOG2E));
                mrow[moff + (unsigned)(rr * 1024 + 32 * vb)] = f2bf(acc[vb][r] * rstd[r] * gg * sg); } }
    }
}
constexpr int AT_K = 0, AT_V = 2 * 64 * RS, AT_STAGE = AT_V + 128 * RS;
constexpr int AT_WSF = 65536;
struct AttnArgs { const bf16_t* proj; const bf16_t* vt; bf16_t* mixed; const float *qg, *kg, *lq1, *lk1, *lq2, *lk2, *dgain; float* parto; float* partl; };
__device__ __forceinline__ int attn_kt0(int h, int qb, float TH) { const float slope2 = exp2f(-2.0f * (float)(h + 1)) * LOG2E; const float v = floorf(((float)(128 * qb - 63) - TH / slope2) * (1.0f / 64.0f)) + 1.0f; return v > 0.f ? (int)v : 0; }
constexpr int SEGT = 64;
__device__ __forceinline__ bool attn_split(int h, int qb, int nt_eff) { return h >= 2 && qb >= 32 && nt_eff > SEGT; }
__device__ __forceinline__ int attn_slot(int b, int h, int qb) { return (b * 2 + (h - 2)) * 32 + (qb - 32); }
__device__ __forceinline__ bool attn_item(LAS unsigned char* lds, const AttnArgs& A, int it, float lam, float M2) {
    int tid_ = threadIdx.x; asm volatile("" : "+v"(tid_)); const int tid = tid_, lane = tid & 63, wid = __builtin_amdgcn_readfirstlane(tid >> 6), r32 = lane & 31, hi = lane >> 5;
    const int g = wid >> 2, w = wid & 3;
    int qb, bh, seg;
    if (it < 384) { qb = 63 - it / 12; const int j = it % 12; if (j < 8) { bh = j; seg = 0; } else { bh = ((j - 8) >> 1) * 4 + 2 + ((j - 8) & 1); seg = 1; } }
    else { const int i2 = it - 384; qb = 31 - (i2 >> 3); bh = i2 & 7; seg = 0; }
    const int b = bh >> 2, h = bh & 3;
    const float TH = 2.0f * M2 + 53.0f;
    const int ntile_all = 2 * qb + 2, kt0 = attn_kt0(h, qb, TH), nt_eff = ntile_all - kt0;
    const bool split = attn_split(h, qb, nt_eff);
    int kt_begin = kt0, kt_end = ntile_all;
    if (split) { const int half = nt_eff >> 1; if (seg == 0) kt_end = kt0 + half; else kt_begin = kt0 + half; }
    else if (seg == 1) return false;
    int kgo[2], klo[2], vgo[2], vlo[2];
#pragma unroll
    for (int i = 0; i < 2; ++i) { const int idx = tid + NTHR * i; const int krow = idx >> 4, kch = idx & 15; kgo[i] = krow * 3072 + kch * 8; klo[i] = AT_K + (kch >> 3) * (64 * RS) + krow * RS + (kch & 7) * 16;
        const int vrow = idx >> 3, vch = idx & 7; vgo[i] = vrow * SEQ + vch * 8; vlo[i] = AT_V + vrow * RS + vch * 16; }
    {
        const float slope2 = exp2f(-2.0f * (float)(h + 1)) * LOG2E;
        const bf16_t* Kg = A.proj + (size_t)b * SEQ * 3072 + 512 + h * 128;
        const bf16_t* Vg = A.vt + (size_t)bh * 128 * SEQ;
        {
            const int q0 = qb * 128;
            const int qpos = q0 + 32 * w + r32;
            bf16x8 qf[4];
#pragma unroll
            for (int ds = 0; ds < 4; ++ds) qf[ds] = *(const bf16x8*)(A.proj + ((size_t)b * SEQ + qpos) * 3072 + h * 128 + g * 64 + 16 * ds + 8 * hi);
            u32x4 kr[2], vr[2];
#pragma unroll
            for (int i = 0; i < 2; ++i) { kr[i] = *(const u32x4*)(Kg + (size_t)(64 * kt_begin) * 3072 + kgo[i]); vr[i] = *(const u32x4*)(Vg + 64 * kt_begin + vgo[i]); }
#pragma unroll
            for (int i = 0; i < 2; ++i) { *(LAS u32x4*)(lds + klo[i]) = kr[i]; *(LAS u32x4*)(lds + vlo[i]) = vr[i]; }
            __syncthreads();
            f32x16 O[4]; O[0] = f32x16{}; O[1] = f32x16{}; O[2] = f32x16{}; O[3] = f32x16{};
            float l = 0.f;
            float cr8[8];
#pragma unroll
            for (int j = 0; j < 8; ++j) cr8[j] = -slope2 * (float)(qpos - (8 * hi + j)) - M2;
            for (int t = kt_begin; t < kt_end; ++t) {
                const int k0 = 64 * t; const bool more = t + 1 < kt_end;
                if (more) {
#pragma unroll
                    for (int i = 0; i < 2; ++i) { kr[i] = *(const u32x4*)(Kg + (size_t)(k0 + 64) * 3072 + kgo[i]); vr[i] = *(const u32x4*)(Vg + (k0 + 64) + vgo[i]); }
                }
                const LAS unsigned char* sp = lds + ((t - kt_begin) & 1) * AT_STAGE;
                if (k0 <= q0 + 32 * w + 31) {
                    bf16x8 kf[8];
#pragma unroll
                    for (int blk = 0; blk < 2; ++blk)
#pragma unroll
                        for (int ds = 0; ds < 4; ++ds) kf[blk * 4 + ds] = *(const LAS bf16x8*)(sp + AT_K + g * (64 * RS) + (32 * blk + pi_row(r32)) * RS + (16 * ds + 8 * hi) * 2);
                    __builtin_amdgcn_sched_barrier(0);
                    f32x16 S[2];
#pragma unroll
                    for (int blk = 0; blk < 2; ++blk) {
                        const float off0 = slope2 * (float)(k0 + 32 * blk), off1 = slope2 * (float)(k0 + 32 * blk + 16);
#pragma unroll
                        for (int r = 0; r < 16; ++r) S[blk][r] = cr8[r & 7] + ((r >> 3) ? off1 : off0);
                    }
#pragma unroll
                    for (int ds = 0; ds < 4; ++ds)
#pragma unroll
                        for (int blk = 0; blk < 2; ++blk) S[blk] = __builtin_amdgcn_mfma_f32_32x32x16_bf16(kf[blk * 4 + ds], qf[ds], S[blk], 0, 0, 0);
                    bf16x8 vfA[4], vfB[4];
#pragma unroll
                    for (int ks = 0; ks < 4; ++ks) vfA[ks] = *(const LAS bf16x8*)(sp + AT_V + r32 * RS + (16 * ks + 8 * hi) * 2);
                    __builtin_amdgcn_sched_barrier(0);
                    const bool needmask = k0 + 63 > q0 + 32 * w;
                    const int dlim = qpos - k0 - 8 * hi;
                    float ls = 0.f;
                    if (needmask) {
#pragma unroll
                        for (int blk = 0; blk < 2; ++blk)
#pragma unroll
                            for (int r = 0; r < 16; ++r) { float pv = __builtin_amdgcn_exp2f(S[blk][r]);
                                if ((32 * blk + 16 * (r >> 3) + (r & 7)) > dlim) pv = 0.f;
                                S[blk][r] = pv; ls += pv; }
                    } else {
                        float ls1 = 0.f;
#pragma unroll
                        for (int blk = 0; blk < 2; ++blk)
#pragma unroll
                            for (int r = 0; r < 16; r += 2) { const float p0 = __builtin_amdgcn_exp2f(S[blk][r]), p1 = __builtin_amdgcn_exp2f(S[blk][r + 1]); S[blk][r] = p0; S[blk][r + 1] = p1; ls += p0; ls1 += p1; }
                        ls += ls1;
                    }
                    l += ls;
                    bf16x8 P[4];
#pragma unroll
                    for (int blk = 0; blk < 2; ++blk) { P[2 * blk] = pack8(S[blk][0], S[blk][1], S[blk][2], S[blk][3], S[blk][4], S[blk][5], S[blk][6], S[blk][7]);
                        P[2 * blk + 1] = pack8(S[blk][8], S[blk][9], S[blk][10], S[blk][11], S[blk][12], S[blk][13], S[blk][14], S[blk][15]); }
#pragma unroll
                    for (int vb = 0; vb < 4; ++vb) {
                        if (vb < 3) {
#pragma unroll
                            for (int ks = 0; ks < 4; ++ks) vfB[ks] = *(const LAS bf16x8*)(sp + AT_V + (32 * (vb + 1) + r32) * RS + (16 * ks + 8 * hi) * 2);
                        }
                        __builtin_amdgcn_sched_barrier(0);
#pragma unroll
                        for (int ks = 0; ks < 4; ++ks) O[vb] = __builtin_amdgcn_mfma_f32_32x32x16_bf16(P[ks], vfA[ks], O[vb], 0, 0, 0);
                        __builtin_amdgcn_sched_barrier(0);
#pragma unroll
                        for (int ks = 0; ks < 4; ++ks) vfA[ks] = vfB[ks];
                    }
                }
                if (more) { LAS unsigned char* dp = lds + ((t + 1 - kt_begin) & 1) * AT_STAGE;
#pragma unroll
                    for (int i = 0; i < 2; ++i) { *(LAS u32x4*)(dp + klo[i]) = kr[i]; *(LAS u32x4*)(dp + vlo[i]) = vr[i]; } }
                __syncthreads();
            }
            l += __shfl_xor(l, 32);
            if (split) {
                const int slot = attn_slot(b, h, qb); const size_t pidx = (size_t)((slot * 2 + seg) * 2 + g) * 4 + w;
                float* po = A.parto + pidx * 4096 + lane;
#pragma unroll
                for (int vb = 0; vb < 4; ++vb)
#pragma unroll
                    for (int r = 0; r < 16; ++r) po[(vb * 16 + r) * 64] = O[vb][r];
                if (hi == 0) A.partl[pidx * 32 + r32] = l;
                return true;
            }
            float dgv[4];
#pragma unroll
            for (int vb = 0; vb < 4; ++vb) dgv[vb] = A.dgain[32 * vb + r32] * 0.8f;
            LAS float* wsf = (LAS float*)(lds + AT_WSF) + wid * 32;
            if (hi == 0) wsf[r32] = 1.0f / l;
            asm volatile("s_waitcnt lgkmcnt(0)" ::: "memory");
            float rl[16];
#pragma unroll
            for (int r = 0; r < 16; ++r) rl[r] = wsf[crow(r, hi)];
            LAS float* X = (LAS float*)lds + (size_t)w * 64 * 64 + lane;
            if (g == 1) {
#pragma unroll
                for (int vb = 0; vb < 4; ++vb)
#pragma unroll
                    for (int r = 0; r < 16; ++r) X[(vb * 16 + r) * 64] = lam * O[vb][r] * rl[r];
            }
            __syncthreads();
            if (g == 0) {
                float rstd[16];
#pragma unroll
                for (int r = 0; r < 16; ++r) { float ss = 0.f;
#pragma unroll
                    for (int vb = 0; vb < 4; ++vb) { const float o = O[vb][r] * rl[r] - X[(vb * 16 + r) * 64]; O[vb][r] = o; ss += o * o; }
                    rstd[r] = ss; }
#pragma unroll
                for (int o = 1; o < 32; o <<= 1) {
#pragma unroll
                    for (int r = 0; r < 16; ++r) rstd[r] += __shfl_xor(rstd[r], o);
                    __builtin_amdgcn_sched_barrier(0); }
#pragma unroll
                for (int r = 0; r < 16; ++r) rstd[r] = rsqrtf(rstd[r] * (1.0f / 128.0f) + RMS_EPS);
                bf16_t* mrow = A.mixed + ((size_t)b * SEQ + q0 + 32 * w) * 1024 + h * 128;
                unsigned loff = (unsigned)(4 * hi * 1024 + r32); asm volatile("" : "+v"(loff));
#pragma unroll
                for (int vb = 0; vb < 4; ++vb) { const float dg = dgv[vb];
#pragma unroll
                    for (int r = 0; r < 16; ++r) mrow[loff + (unsigned)(((r & 3) + 8 * (r >> 2)) * 1024 + 32 * vb)] = f2bf(O[vb][r] * rstd[r] * dg); }
            }
            __syncthreads();
        }
    }
    return false;
}
__device__ __forceinline__ void attn_finalize(const AttnArgs& A, int wt, float lam, float M2) {
    int tid_ = threadIdx.x; asm volatile("" : "+v"(tid_)); const int lane = tid_ & 63, r32 = lane & 31, hi = lane >> 5;
    const int slot = wt >> 2, w = wt & 3; const int b = slot >> 6, h = 2 + ((slot >> 5) & 1), qb = 32 + (slot & 31);
    const float TH = 2.0f * M2 + 53.0f; const int nt_eff = 2 * qb + 2 - attn_kt0(h, qb, TH);
    if (!attn_split(h, qb, nt_eff)) return;
    float rl[2][16];
#pragma unroll
    for (int g = 0; g < 2; ++g)
#pragma unroll
        for (int r = 0; r < 16; ++r) { const int q = crow(r, hi); rl[g][r] = 1.0f / (A.partl[((size_t)((slot * 2 + 0) * 2 + g) * 4 + w) * 32 + q] + A.partl[((size_t)((slot * 2 + 1) * 2 + g) * 4 + w) * 32 + q]); }
    float dgv[4];
#pragma unroll
    for (int vb = 0; vb < 4; ++vb) dgv[vb] = A.dgain[32 * vb + r32];
    float o[4][16]; float rstd[16];
#pragma unroll
    for (int r = 0; r < 16; ++r) { float ss = 0.f;
#pragma unroll
        for (int vb = 0; vb < 4; ++vb) { const int e = (vb * 16 + r) * 64 + lane;
            const float o0 = A.parto[((size_t)((slot * 2 + 0) * 2 + 0) * 4 + w) * 4096 + e] + A.parto[((size_t)((slot * 2 + 1) * 2 + 0) * 4 + w) * 4096 + e];
            const float o1 = A.parto[((size_t)((slot * 2 + 0) * 2 + 1) * 4 + w) * 4096 + e] + A.parto[((size_t)((slot * 2 + 1) * 2 + 1) * 4 + w) * 4096 + e];
            const float v = o0 * rl[0][r] - lam * o1 * rl[1][r]; o[vb][r] = v; ss += v * v; }
        rstd[r] = ss; }
#pragma unroll
    for (int x = 1; x < 32; x <<= 1) {
#pragma unroll
        for (int r = 0; r < 16; ++r) rstd[r] += __shfl_xor(rstd[r], x);
        __builtin_amdgcn_sched_barrier(0); }
#pragma unroll
    for (int r = 0; r < 16; ++r) rstd[r] = rsqrtf(rstd[r] * (1.0f / 128.0f) + RMS_EPS);
    bf16_t* mrow = A.mixed + ((size_t)b * SEQ + qb * 128 + 32 * w) * 1024 + h * 128;
    unsigned loff = (unsigned)(4 * hi * 1024 + r32); asm volatile("" : "+v"(loff));
#pragma unroll
    for (int vb = 0; vb < 4; ++vb) { const float dg = dgv[vb] * 0.8f;
#pragma unroll
        for (int r = 0; r < 16; ++r) mrow[loff + (unsigned)(((r & 3) + 8 * (r >> 2)) * 1024 + 32 * vb)] = f2bf(o[vb][r] * rstd[r] * dg); }
}
__device__ __forceinline__ void attn_consts(const AttnArgs& A, float& lam, float& M2) {
    int tid_ = threadIdx.x; asm volatile("" : "+v"(tid_)); const int lane = tid_ & 63;
    lam = __expf(wave_sum(A.lq1[lane] * A.lk1[lane])) - __expf(wave_sum(A.lq2[lane] * A.lk2[lane])) + 0.2f;
    M2 = 8.0f * wave_max(fabsf(A.qg[lane])) * wave_max(fabsf(A.kg[lane])) * LOG2E;
    lam = __uint_as_float(__builtin_amdgcn_readfirstlane(__float_as_uint(lam))); M2 = __uint_as_float(__builtin_amdgcn_readfirstlane(__float_as_uint(M2)));
}
#define XB_TMO      128
#define XB_XCNT(j)  (256  + 64 * (j))
#define XB_XSUB(j)  (1280 + 64 * (j))
#define XB_XGEN(j)  (2304 + 64 * (j))
#define XB_TOP      3328
#define XB_TOPGEN   3392
#define XCD_BAR_WORDS 3456
#define XB_SPIN_CAP (1u << 18)

__device__ __forceinline__ unsigned xb_ld(unsigned* p)              { return __hip_atomic_load(p, __ATOMIC_RELAXED, __HIP_MEMORY_SCOPE_AGENT); }
__device__ __forceinline__ unsigned xb_add(unsigned* p, unsigned v) { return __hip_atomic_fetch_add(p, v, __ATOMIC_RELAXED, __HIP_MEMORY_SCOPE_AGENT); }
__device__ __forceinline__ unsigned xb_xcc_id() { return (unsigned)__builtin_amdgcn_s_getreg((3 << 11) | 20) & 0xFu; }
#define XB_SPIN(cond, bar) do { unsigned _sp = 0; while (cond) { __builtin_amdgcn_s_sleep(1); \
    if ((++_sp & 255u) == 0u) { if (xb_ld(&(bar)[XB_TMO])) break; if (_sp > XB_SPIN_CAP) { atomicAdd(&(bar)[XB_TMO], 1u); break; } } } } while (0)

struct XcdBarrier {
    unsigned* bar; unsigned x;
    volatile LAS unsigned* st;
};

__device__ __forceinline__ XcdBarrier xcd_barrier_post(unsigned* bar, volatile LAS unsigned* st) {
    XcdBarrier b; b.bar = bar; b.x = xb_xcc_id(); b.st = st;
    if (threadIdx.x == 0) (void)xb_add(&bar[XB_XCNT(b.x)], 1u);
    return b;
}
__device__ __forceinline__ void xcd_barrier_complete(unsigned* bar, unsigned x, unsigned& nloc, unsigned& nx) {
    const unsigned G = gridDim.x * gridDim.y * gridDim.z;
    unsigned sum, cnt, mine, sp = 0u;
    for (;;) {
        sum = 0u; cnt = 0u; mine = 0u;
#pragma unroll
        for (unsigned j = 0; j < 16; ++j) { const unsigned c = xb_ld(&bar[XB_XCNT(j)]); sum += c; cnt += (c > 0u) ? 1u : 0u; mine = (j == x) ? c : mine; }
        if (sum == G) break;
        __builtin_amdgcn_s_sleep(1);
        if ((++sp & 255u) == 0u) { if (xb_ld(&bar[XB_TMO])) break; if (sp > XB_SPIN_CAP) { atomicAdd(&bar[XB_TMO], 1u); break; } }
    }
    nloc = mine > 0u ? mine : 1u; nx = cnt > 0u ? cnt : 1u;
}

__device__ __forceinline__ void xcd_barrier(const XcdBarrier& b) {
    asm volatile("s_waitcnt vmcnt(0)" ::: "memory");
    __syncthreads();
    if (threadIdx.x == 0) {
        unsigned* bar = b.bar;
        __builtin_amdgcn_s_waitcnt(0);
        unsigned nloc = b.st[0], nx = b.st[1];
        if (nloc == 0u) { xcd_barrier_complete(bar, b.x, nloc, nx); b.st[0] = nloc; b.st[1] = nx; }
        const unsigned old = xb_add(&bar[XB_XSUB(b.x)], 1u);
        const unsigned gen = old / nloc;
        if (old + 1u == (gen + 1u) * nloc) {
            __builtin_amdgcn_fence(__ATOMIC_RELEASE, "agent");
            asm volatile("s_waitcnt vmcnt(0)" ::: "memory");
            const unsigned og = xb_add(&bar[XB_TOP], 1u);
            const unsigned tg = og / nx;
            if (og + 1u == (tg + 1u) * nx) xb_add(&bar[XB_TOPGEN], 1u);
            else XB_SPIN(xb_ld(&bar[XB_TOPGEN]) == tg, bar);
            __builtin_amdgcn_fence(__ATOMIC_ACQUIRE, "agent");
            xb_add(&bar[XB_XGEN(b.x)], 1u);
            asm volatile("s_waitcnt vmcnt(0)" ::: "memory");
        } else {
            XB_SPIN(xb_ld(&bar[XB_XGEN(b.x)]) == gen, bar);
            __builtin_amdgcn_fence(__ATOMIC_ACQUIRE, "agent");
            asm volatile("s_waitcnt vmcnt(0)" ::: "memory");
        }
    }
    __syncthreads();
}

constexpr int MISC_OFF = 131072 + 320;
#ifndef MK_N_LAUNCHES
#define MK_N_LAUNCHES 1
#endif
constexpr int NPHASE = 9;
struct Args { const float* in[18]; float* out; unsigned char* ws; int ph_lo, ph_hi; };
__global__ void __launch_bounds__(NTHR, 2) fwd_megakernel(Args a) {
    extern __shared__ __attribute__((aligned(16))) unsigned char lds_raw[];
    LAS unsigned char* lds = (LAS unsigned char*)lds_raw;
    cg::grid_group grid = cg::this_grid();
    const int G = gridDim.x, bid = blockIdx.x;
    unsigned char* ws = a.ws;
    volatile LAS unsigned* MISC = (volatile LAS unsigned*)(lds + MISC_OFF);
    if (threadIdx.x < 32) MISC[threadIdx.x] = 0u;
    __syncthreads();
    XcdBarrier bar = xcd_barrier_post((unsigned*)(ws + WS_BAR), MISC + 8);
    if (a.ph_lo < 0) grid.sync();
    const float* x = a.in[0];
    bf16_t* WinT = (bf16_t*)(ws + WS_WIN); bf16_t* WoT = (bf16_t*)(ws + WS_WO); bf16_t* WguT = (bf16_t*)(ws + WS_WGU); bf16_t* WdT = (bf16_t*)(ws + WS_WD);
    float* glr = (float*)(ws + WS_GLR); float* dvec = (float*)(ws + WS_DVEC); float* rowss = (float*)(ws + WS_ROWSS);
    bf16_t* XN = (bf16_t*)(ws + WS_XN); bf16_t* PROJ = (bf16_t*)(ws + WS_PROJ); bf16_t* VT = (bf16_t*)(ws + WS_VT); bf16_t* GVT = (bf16_t*)(ws + WS_GVT);
    bf16_t* MIX = (bf16_t*)(ws + WS_MIX); float* ST = (float*)(ws + WS_ST);
    float* OINTRA = a.out; bf16_t* SB = (bf16_t*)((unsigned char*)a.out + 16 * MiB); bf16_t* QT = (bf16_t*)((unsigned char*)a.out + 32 * MiB);
    bf16_t* HB = XN; bf16_t* HID = PROJ;
    float* PARTO = (float*)(ws + WS_XN); float* PARTL = (float*)((unsigned char*)a.out + 40 * MiB);
    const int lo = a.ph_lo, hi = a.ph_hi;
#define IN(k) (lo <= (k) && (k) < hi)
#ifndef REPEAT_MASK
#define REPEAT_MASK 0
#endif
#define REP(k) (((REPEAT_MASK >> (k)) & 1) ? 2 : 1)
#define SEAM(k) do { if (IN(k) && IN((k) + 1)) xcd_barrier(bar); } while (0)
    if (IN(0)) for (int rep_ = 0; rep_ < REP(0); ++rep_) { P0Args P{x, a.in[1], a.in[2], a.in[13], a.in[14], a.in[15], a.in[16], a.in[17], WinT, WoT, WguT, WdT, XN, glr, rowss}; p0_prologue(lds, P, G, bid); }
    SEAM(0);
    if (IN(1)) for (int rep_ = 0; rep_ < REP(1); ++rep_) { pg8::Gemm g{XN, WinT, M, 3072, 1024}; pg8::StaticOrder S; S.init(M, 3072, G, bid);
        pg8::EpiInProj E{PROJ, VT, GVT, a.in[3], a.in[4]};
        pg8::gemm_phase<pg8::EpiInProj, pg8::StaticOrder, true, true>(lds, g, S, E); }
    SEAM(1);
    if (IN(2)) { GlaArgs GA{PROJ, GVT, glr, a.in[10], a.in[11], QT, OINTRA, ST, dvec}; Gla3Args GB{PROJ, QT, OINTRA, SB, a.in[12], MIX};
        AttnArgs AA{PROJ, VT, MIX, a.in[3], a.in[4], a.in[5], a.in[6], a.in[7], a.in[8], a.in[9], PARTO, PARTL};
        P0Args PW{x, a.in[1], a.in[2], a.in[13], a.in[14], a.in[15], a.in[16], a.in[17], WinT, WoT, WguT, WdT, XN, glr, rowss};
        float lam, M2; attn_consts(AA, lam, M2);
        unsigned* qhead = (unsigned*)(ws + WS_QHEAD); unsigned* g1done = qhead + 64; unsigned* scandone = qhead + 128; unsigned* splitdone = qhead + 192;
        const int wid_ = __builtin_amdgcn_readfirstlane(threadIdx.x >> 6);
        int nsplit;
        { const float TH = 2.0f * M2 + 53.0f; const int l_ = threadIdx.x & 63; float sp_ = 0.f;
#pragma unroll
          for (int q_ = 0; q_ < 2; ++q_) { const int t_ = l_ + 64 * q_; const int h_ = 2 + ((t_ >> 5) & 1), qb_ = 32 + (t_ & 31); sp_ += attn_split(h_, qb_, 2 * qb_ + 2 - attn_kt0(h_, qb_, TH)) ? 1.f : 0.f; }
          nsplit = __builtin_amdgcn_readfirstlane((int)(wave_sum(sp_) + 0.5f)); }
        constexpr int Q_A1 = 256, Q_SC = Q_A1 + 256, Q_A2 = Q_SC + 128, Q_FN = Q_A2 + 384, Q_G3 = Q_FN + 64, Q_LW = Q_G3 + 256, Q_END = Q_LW + LW_BLOCK_ITEMS;
        unsigned nxt_ = 0u;
        if (threadIdx.x == 0) nxt_ = __hip_atomic_fetch_add(qhead, 1u, __ATOMIC_RELAXED, __HIP_MEMORY_SCOPE_AGENT);
        for (;;) {
            if (threadIdx.x == 0) MISC[0] = nxt_;
            __syncthreads();
            const int it = __builtin_amdgcn_readfirstlane((int)MISC[0]);
            __syncthreads();
            if (it >= Q_END) break;
            const int ty = it < Q_A1 ? 0 : it < Q_SC ? 1 : it < Q_A2 ? 2 : it < Q_FN ? 1 : it < Q_G3 ? 3 : it < Q_LW ? 4 : 5;
            unsigned* wcnt = ty == 2 ? g1done : ty == 3 ? splitdone : ty == 4 ? scandone : nullptr;
            const unsigned want = ty == 2 ? 256u : ty == 3 ? 2u * (unsigned)nsplit : 128u;
            item_wait(wcnt, want);
            unsigned* dcnt = nullptr;
            if (ty == 0) { gla_chunk_quad(lds, GA, 4 * it); dcnt = g1done; }
            else if (ty == 1) { const int ai = it < Q_SC ? it - Q_A1 : it - Q_A2 + 256; if (attn_item(lds, AA, ai, lam, M2)) dcnt = splitdone; }
            else if (ty == 2) { gla_scan_item(ST, SB, dvec, it - Q_SC); dcnt = scandone; }
            else if (ty == 3) attn_finalize(AA, (it - Q_FN) * NWAVES + wid_, lam, M2);
            else if (ty == 4) gla_out_task(GB, (it - Q_G3) * NWAVES + wid_);
            else late_weights_item(lds, PW, it - Q_LW);
            if (threadIdx.x == 0) nxt_ = __hip_atomic_fetch_add(qhead, 1u, __ATOMIC_RELAXED, __HIP_MEMORY_SCOPE_AGENT);
            item_done(dcnt);
        }
    }
    SEAM(2);
    if (IN(6)) for (int rep_ = 0; rep_ < REP(6); ++rep_) { pg8::Gemm g{MIX, WoT, M, 1024, 1024}; pg8::StaticOrder S; S.init(M, 1024, G, bid);
        pg8::EpiOut E{x, a.out, HB, rowss};
        pg8::gemm_phase<pg8::EpiOut, pg8::StaticOrder, false, true>(lds, g, S, E); }
    SEAM(6);
    if (IN(7)) for (int rep_ = 0; rep_ < REP(7); ++rep_) { pg8::Gemm g{HB, WguT, M, 2 * DFF, 1024}; pg8::StaticOrder S; S.init(M, 2 * DFF, G, bid);
        pg8::EpiSwiGLU E{HID, rowss};
        pg8::gemm_phase<pg8::EpiSwiGLU, pg8::StaticOrder, true, true>(lds, g, S, E); }
    SEAM(7);
    if (IN(8)) for (int rep_ = 0; rep_ < REP(8); ++rep_) { pg8::Gemm g{HID, WdT, M, 1024, DFF}; pg8::StaticOrder S; S.init(M, 1024, G, bid);
        pg8::EpiDown E{a.out, HB};
        pg8::gemm_phase<pg8::EpiDown, pg8::StaticOrder, false, true>(lds, g, S, E); }
#undef IN
#undef SEAM
}

extern "C" void kernel_launch(void* const* d_in, const int* in_sizes, int n_in, void* d_out, int out_size, void* d_ws, size_t ws_size, hipStream_t stream) {
    static int grid = 0;
    if (grid == 0) {
        if (n_in != 18 || out_size != M * DM || ws_size < WS_END) { fprintf(stderr, "kernel_launch: unexpected shapes (n_in %d, out %d, ws %zu)\n", n_in, out_size, ws_size); grid = -1; return; }
        int dev = 0, cus = 0, per_cu = 0;
        hipGetDevice(&dev); hipDeviceGetAttribute(&cus, hipDeviceAttributeMultiprocessorCount, dev);
        hipFuncSetAttribute((const void*)fwd_megakernel, hipFuncAttributeMaxDynamicSharedMemorySize, LDS_BYTES);
        if (hipOccupancyMaxActiveBlocksPerMultiprocessor(&per_cu, (const void*)fwd_megakernel, NTHR, LDS_BYTES) != hipSuccess || per_cu < 1) per_cu = 1;
        (void)hipGetLastError();
        grid = cus * per_cu;
        if (grid < 1) grid = 256;
    }
    if (grid < 0) return;
    if (hipMemsetAsync((char*)d_ws + WS_BAR, 0, 16384, stream) != hipSuccess) { fprintf(stderr, "kernel_launch: memset failed\n"); return; }
    Args a{};
    for (int i = 0; i < 18; ++i) a.in[i] = (const float*)d_in[i];
    a.out = (float*)d_out; a.ws = (unsigned char*)d_ws;
#if MK_N_LAUNCHES == 1
    a.ph_lo = 0; a.ph_hi = NPHASE;
    void* args[] = {&a};
    hipError_t e = hipLaunchCooperativeKernel((const void*)fwd_megakernel, dim3(grid), dim3(NTHR), args, LDS_BYTES, stream);
    if (e != hipSuccess) fprintf(stderr, "cooperative launch failed: %s (grid %d)\n", hipGetErrorString(e), grid);
#else
    for (int ph = 0; ph < NPHASE; ++ph) { a.ph_lo = ph; a.ph_hi = ph + 1; hipLaunchKernelGGL(fwd_megakernel, dim3(grid), dim3(NTHR), LDS_BYTES, stream, a); }
#endif
}
```

```cpp
#include <hip/hip_runtime.h>
#include <hip/hip_cooperative_groups.h>
#include <cstdio>
#include <cstdint>
namespace cg = cooperative_groups;
#define MK_N_LAUNCHES 1
#define REPEAT_MASK 0

namespace pg8 {
#define PG8_LAS __attribute__((address_space(3)))
typedef unsigned short bf16_t;
typedef short bf16x8 __attribute__((ext_vector_type(8)));
typedef float f32x4 __attribute__((ext_vector_type(4)));
typedef unsigned u32x4 __attribute__((ext_vector_type(4)));
constexpr int BM = 256, BK = 64, HALF = 128, HTB = HALF * BK * 2  , STAGE_BYTES = 8 * HTB, NXCD = 8, WGM = 8;

__host__ __device__ __forceinline__ int lds_byte(int r, int c) { const int st = (r >> 4) * 2 + (c >> 5), rr = r & 15, cc = c & 31, ob = rr * 64 + cc * 2; return st * 1024 + (ob ^ (((ob >> 9) & 1) << 5)); }
__host__ __device__ __forceinline__ void stage_rc(int b, int& R, int& C) { const int st = b / 1024, sb = b % 1024, swz = sb ^ (((sb >> 9) & 1) << 5); R = (st >> 1) * 16 + swz / 64; C = (st & 1) * 32 + (swz % 64) / 2; }
__host__ __device__ __forceinline__ int perm32(int rho) { const int n = rho >> 4, i = rho & 15; return 8 * (i >> 2) + 4 * n + (i & 3); }

struct Unit { int pm, pn; };
struct Gemm { const bf16_t* A; const bf16_t* Bt; int M, N, K; };

struct StaticOrder {
    int nM, nN, nwg, G, c;
    __host__ __device__ void init(int M, int N, int G_, int c_) { nM = M / BM; nN = N / BM; nwg = nM * nN; G = G_; c = c_; }
    __host__ __device__ bool next(int i, Unit& u) const {
        const long L = (long)i * G + c; if (L >= nwg) return false;
        int wgid = (int)L; { const int q = nwg / NXCD, r = nwg % NXCD, xcd = wgid % NXCD, off = wgid / NXCD; wgid = (xcd < r ? xcd * (q + 1) : r * (q + 1) + (xcd - r) * q) + off; }
        const int nig = WGM * nN, gid = wgid / nig, fm = gid * WGM, gsz = (nM - fm) < WGM ? (nM - fm) : WGM;
        u.pm = fm + ((wgid % nig) % gsz); u.pn = (wgid % nig) / gsz; return true;
    }
    __device__ __forceinline__ void a_ready(const Unit&) const {}
    __device__ __forceinline__ void done(const Unit&) const {}
};

__device__ __forceinline__ unsigned cvt_pk_bf16(float lo, float hi) { unsigned r; asm volatile("v_cvt_pk_bf16_f32 %0, %1, %2" : "=v"(r) : "v"(lo), "v"(hi)); return r; }
typedef float f32x2 __attribute__((ext_vector_type(2)));
typedef unsigned u32x2 __attribute__((ext_vector_type(2)));
typedef float f32x2_t __attribute__((ext_vector_type(2))); typedef __bf16 bf16x2_t __attribute__((ext_vector_type(2)));
__device__ __forceinline__ unsigned cvtpk(float lo, float hi) { f32x2_t v = {lo, hi}; bf16x2_t b = __builtin_convertvector(v, bf16x2_t); return __builtin_bit_cast(unsigned, b); }
constexpr float RMS_EPS = 1e-6f;
constexpr float LOG2E = 1.4426950408889634f;
constexpr int PROJ_LD = 3072;

struct EpiInProj {
    static constexpr bool PERM = true, AFTER_DRAIN = false;
    bf16_t* proj; bf16_t* vt; bf16_t* gvt; const float* qg; const float* kg;
    __device__ __forceinline__ void operator()(const f32x4 (&acc)[2][2][4][2], const Unit& u, int wr, int wc, int fr, int fq) const {
        const int pn = u.pn; const int row0 = u.pm * BM + wr * 64 + fr;
        if (pn < 4) {
            const float* g = pn < 2 ? qg : kg; const float sc = pn < 2 ? 0.125f * LOG2E : 1.0f;
            f32x4 gv[2][2];
#pragma unroll
            for (int bj = 0; bj < 2; ++bj)
#pragma unroll
                for (int n = 0; n < 2; ++n) gv[bj][n] = *(const f32x4*)(g + 32 * bj + 8 * fq + 4 * n) * sc;
#pragma unroll
            for (int ai = 0; ai < 2; ++ai)
#pragma unroll
                for (int m = 0; m < 4; ++m) {
                    float ss = 0.f;
#pragma unroll
                    for (int bj = 0; bj < 2; ++bj)
#pragma unroll
                        for (int n = 0; n < 2; ++n) { const f32x4 x = acc[ai][bj][m][n]; ss += (x[0] * x[0] + x[1] * x[1]) + (x[2] * x[2] + x[3] * x[3]); }
                    ss += __shfl_xor(ss, 16); ss += __shfl_xor(ss, 32);
                    const float rstd = rsqrtf(ss * (1.0f / 64.0f) + RMS_EPS);
                    bf16_t* rowp = proj + (size_t)(row0 + ai * HALF + m * 16) * PROJ_LD + pn * 256 + wc * 64 + 8 * fq;
#pragma unroll
                    for (int bj = 0; bj < 2; ++bj) { const f32x4 v0 = acc[ai][bj][m][0] * rstd * gv[bj][0], v1 = acc[ai][bj][m][1] * rstd * gv[bj][1];
                        u32x4 w; w.x = cvtpk(v0[0], v0[1]); w.y = cvtpk(v0[2], v0[3]); w.z = cvtpk(v1[0], v1[1]); w.w = cvtpk(v1[2], v1[3]);
                        *(u32x4*)(rowp + 32 * bj) = w; }
                }
        } else if (pn == 4 || pn == 5 || pn == 8 || pn == 9) {
            bf16_t* dst = pn < 6 ? vt : gvt; const int cb = (pn & 1) * 256 + wc * 64 + 8 * fq;
#pragma unroll
            for (int ai = 0; ai < 2; ++ai)
#pragma unroll
                for (int m = 0; m < 4; ++m) { const int row = row0 + ai * HALF + m * 16; const int b = row >> 13, t = row & 8191;
#pragma unroll
                    for (int bj = 0; bj < 2; ++bj)
#pragma unroll
                        for (int n = 0; n < 2; ++n) { const f32x4 x = acc[ai][bj][m][n]; const int c = cb + 32 * bj + 4 * n; const int h = c >> 7, ev = c & 127;
                            bf16_t* p = dst + ((size_t)((b * 4 + h) * 128 + ev)) * 8192 + t; const unsigned w0 = cvtpk(x[0], x[1]), w1 = cvtpk(x[2], x[3]);
                            p[0] = (bf16_t)(w0 & 0xffffu); p[8192] = (bf16_t)(w0 >> 16); p[2 * 8192] = (bf16_t)(w1 & 0xffffu); p[3 * 8192] = (bf16_t)(w1 >> 16); }
                }
        } else {
            const float sc = pn == 6 ? 0.125f : 1.0f;
#pragma unroll
            for (int ai = 0; ai < 2; ++ai)
#pragma unroll
                for (int m = 0; m < 4; ++m) { bf16_t* rowp = proj + (size_t)(row0 + ai * HALF + m * 16) * PROJ_LD + pn * 256 + wc * 64 + 8 * fq;
#pragma unroll
                    for (int bj = 0; bj < 2; ++bj) { const f32x4 v0 = acc[ai][bj][m][0] * sc, v1 = acc[ai][bj][m][1] * sc;
                        u32x4 w; w.x = cvtpk(v0[0], v0[1]); w.y = cvtpk(v0[2], v0[3]); w.z = cvtpk(v1[0], v1[1]); w.w = cvtpk(v1[2], v1[3]);
                        *(u32x4*)(rowp + 32 * bj) = w; }
                }
        }
    }
};
struct EpiOut {
    static constexpr bool PERM = true, AFTER_DRAIN = false;
    const float* x; float* hout; bf16_t* hb; float* rowss;
    __device__ __forceinline__ void operator()(const f32x4 (&acc)[2][2][4][2], const Unit& u, int wr, int wc, int fr, int fq) const {
        const int row0 = u.pm * BM + wr * 64 + fr, col0 = u.pn * BM + wc * 32 + 8 * fq;
#pragma unroll
        for (int ai = 0; ai < 2; ++ai) {
            f32x4 pre[4][2][2];
#pragma unroll
            for (int m = 0; m < 4; ++m) { const size_t off = (size_t)(row0 + ai * HALF + m * 16) * 1024 + col0;
#pragma unroll
                for (int bj = 0; bj < 2; ++bj)
#pragma unroll
                    for (int n = 0; n < 2; ++n) pre[m][bj][n] = *(const f32x4*)(x + off + bj * HALF + n * 4); }
            asm volatile("" ::: "memory");
#pragma unroll
            for (int m = 0; m < 4; ++m) { const int row = row0 + ai * HALF + m * 16; const size_t off = (size_t)row * 1024 + col0; float ss = 0.f;
#pragma unroll
                for (int bj = 0; bj < 2; ++bj) { const f32x4 h0 = pre[m][bj][0] + acc[ai][bj][m][0], h1 = pre[m][bj][1] + acc[ai][bj][m][1];
                    ss += ((h0[0] * h0[0] + h0[1] * h0[1]) + (h0[2] * h0[2] + h0[3] * h0[3])) + ((h1[0] * h1[0] + h1[1] * h1[1]) + (h1[2] * h1[2] + h1[3] * h1[3]));
                    u32x4 w; w.x = cvtpk(h0[0], h0[1]); w.y = cvtpk(h0[2], h0[3]); w.z = cvtpk(h1[0], h1[1]); w.w = cvtpk(h1[2], h1[3]); *(u32x4*)(hb + off + bj * HALF) = w; }
                ss += __shfl_xor(ss, 16); ss += __shfl_xor(ss, 32);
                if (fq == 0) atomicAdd(rowss + row, ss);
            }
            asm volatile("" ::: "memory");
        }
    }
};
struct EpiSwiGLU {
    static constexpr bool PERM = true, AFTER_DRAIN = false;
    bf16_t* hid; const float* rowss;
    __device__ __forceinline__ void operator()(const f32x4 (&acc)[2][2][4][2], const Unit& u, int wr, int wc, int fr, int fq) const {
        const int row0 = u.pm * BM + wr * 64 + fr, col0 = u.pn * 128 + wc * 32 + 8 * fq;
        float rs[2][4];
#pragma unroll
        for (int ai = 0; ai < 2; ++ai)
#pragma unroll
            for (int m = 0; m < 4; ++m) rs[ai][m] = rowss[row0 + ai * HALF + m * 16];
        asm volatile("" ::: "memory");
#pragma unroll
        for (int ai = 0; ai < 2; ++ai)
#pragma unroll
            for (int m = 0; m < 4; ++m) { const int row = row0 + ai * HALF + m * 16; const float r = rsqrtf(rs[ai][m] * (1.0f / 1024.0f) + RMS_EPS);
                float hv[8];
#pragma unroll
                for (int n = 0; n < 2; ++n)
#pragma unroll
                    for (int e = 0; e < 4; ++e) { const float g = acc[ai][0][m][n][e] * r, uu = acc[ai][1][m][n][e] * r;
                        hv[4 * n + e] = g * __builtin_amdgcn_rcpf(1.0f + __builtin_amdgcn_exp2f(-g * LOG2E)) * uu; }
                u32x4 w; w.x = cvtpk(hv[0], hv[1]); w.y = cvtpk(hv[2], hv[3]); w.z = cvtpk(hv[4], hv[5]); w.w = cvtpk(hv[6], hv[7]);
                *(u32x4*)(hid + (size_t)row * 2816 + col0) = w; }
    }
};
struct EpiDown {
    static constexpr bool PERM = true, AFTER_DRAIN = false;
    float* out; const bf16_t* hb;
    __device__ __forceinline__ void operator()(const f32x4 (&acc)[2][2][4][2], const Unit& u, int wr, int wc, int fr, int fq) const {
        const int row0 = u.pm * BM + wr * 64 + fr, col0 = u.pn * BM + wc * 32 + 8 * fq;
#pragma unroll
        for (int ai = 0; ai < 2; ++ai) {
            u32x4 pre[4][2];
#pragma unroll
            for (int m = 0; m < 4; ++m) { const size_t off = (size_t)(row0 + ai * HALF + m * 16) * 1024 + col0;
#pragma unroll
                for (int bj = 0; bj < 2; ++bj) pre[m][bj] = *(const u32x4*)(hb + off + bj * HALF); }
            asm volatile("" ::: "memory");
#pragma unroll
            for (int m = 0; m < 4; ++m) { const size_t off = (size_t)(row0 + ai * HALF + m * 16) * 1024 + col0;
#pragma unroll
                for (int bj = 0; bj < 2; ++bj) { const u32x4 hw = pre[m][bj];
                    f32x4 h0, h1;
                    h0[0] = __uint_as_float(hw.x << 16); h0[1] = __uint_as_float(hw.x & 0xffff0000u); h0[2] = __uint_as_float(hw.y << 16); h0[3] = __uint_as_float(hw.y & 0xffff0000u);
                    h1[0] = __uint_as_float(hw.z << 16); h1[1] = __uint_as_float(hw.z & 0xffff0000u); h1[2] = __uint_as_float(hw.w << 16); h1[3] = __uint_as_float(hw.w & 0xffff0000u);
                    *(f32x4*)(out + off + bj * HALF) = h0 + acc[ai][bj][m][0]; *(f32x4*)(out + off + bj * HALF + 4) = h1 + acc[ai][bj][m][1]; } }
            asm volatile("" ::: "memory");
        }
    }
};
template <class Epi, class Sched, bool ALIGN_EPI = false, bool SP2 = false>
__device__ __forceinline__ void gemm_phase(PG8_LAS unsigned char* lds, const Gemm g, const Sched& S, const Epi& E) {
    int tid_ = threadIdx.x; asm volatile("" : "+v"(tid_)); const int tid = tid_, wid = __builtin_amdgcn_readfirstlane(tid >> 6), lane = tid & 63, wr = wid >> 2, wc = wid & 3, fr = lane & 15, fq = lane >> 4;
    const int K = g.K, nt = K / BK;
    unsigned voffA[2], voffB[2];
#pragma unroll
    for (int i = 0; i < 2; ++i) { int R, C; stage_rc(tid * 16 + i * 8192, R, C); const int Rb = Epi::PERM ? ((R & ~31) + perm32(R & 31)) : R;
        voffA[i] = (unsigned)(R * K + C) * 2u; voffB[i] = (unsigned)(Rb * K + C) * 2u; }
    const size_t kstep = (size_t)(BK * 2);
    const size_t hstep = (size_t)HALF * K * 2;
    const size_t tstep = 2 * hstep;
    const unsigned ldsw = (unsigned)wid * 1024u;
    const int aoff = lds_byte(wr * 64 + fr, fq * 8), boff = lds_byte(wc * 32 + fr, fq * 8);
#define PG8_SA(b, h) (((b) * 2 + (h)) * HTB)
#define PG8_SB(b, h) ((4 + (b) * 2 + (h)) * HTB)
#define PG8_STAGE(bufoff, gbase, voff) do { _Pragma("unroll") for (int _i = 0; _i < 2; ++_i) \
        __builtin_amdgcn_global_load_lds((const unsigned*)((const char*)(gbase) + (voff)[_i]), (PG8_LAS unsigned*)(lds + (bufoff) + ldsw + _i * 8192), 16, 0, 0); } while (0)
#define PG8_LDA(dst, b, h) do { _Pragma("unroll") for (int m = 0; m < 4; ++m) _Pragma("unroll") for (int k = 0; k < 2; ++k) dst[m][k] = *(const PG8_LAS bf16x8*)(lds + PG8_SA(b, h) + aoff + m * 2048 + k * 1024); } while (0)
#define PG8_LDB(dst, b, h) do { _Pragma("unroll") for (int n = 0; n < 2; ++n) _Pragma("unroll") for (int k = 0; k < 2; ++k) dst[n][k] = *(const PG8_LAS bf16x8*)(lds + PG8_SB(b, h) + boff + n * 2048 + k * 1024); } while (0)
#define PG8_MMA(ai, bj, At, Bt) do { __builtin_amdgcn_s_setprio(1); _Pragma("unroll") for (int m = 0; m < 4; ++m) _Pragma("unroll") for (int n = 0; n < 2; ++n) _Pragma("unroll") for (int k = 0; k < 2; ++k) \
        acc[ai][bj][m][n] = __builtin_amdgcn_mfma_f32_16x16x32_bf16(Bt[n][k], At[m][k], acc[ai][bj][m][n], 0, 0, 0); __builtin_amdgcn_s_setprio(0); } while (0)
#define PG8_WAIT_V(n) asm volatile("s_waitcnt vmcnt(" #n ")" ::: "memory")
#define PG8_WAIT_L(n) asm volatile("s_waitcnt lgkmcnt(" #n ")" ::: "memory")
#define PG8_BAR __builtin_amdgcn_s_barrier()
#define PG8_SCHED __builtin_amdgcn_sched_barrier(0)
    Unit cur, nxt; int ui = 0;
    if (!S.next(0, cur)) return;
    f32x4 acc[2][2][4][2];
#pragma unroll
    for (int a = 0; a < 2; ++a)
#pragma unroll
        for (int b = 0; b < 2; ++b)
#pragma unroll
            for (int m = 0; m < 4; ++m)
#pragma unroll
                for (int n = 0; n < 2; ++n) acc[a][b][m][n] = (f32x4){0.f, 0.f, 0.f, 0.f};
    bf16x8 At[4][2], B0[2][2], B1[2][2];
    const char* cA = (const char*)g.A + (size_t)cur.pm * tstep; const char* cB = (const char*)g.Bt + (size_t)cur.pn * tstep;
    S.a_ready(cur);
    if constexpr (SP2) {
        PG8_STAGE(PG8_SB(0, 0), cB, voffB); PG8_STAGE(PG8_SB(0, 1), cB + hstep, voffB); PG8_STAGE(PG8_SA(0, 0), cA, voffA); PG8_STAGE(PG8_SA(0, 1), cA + hstep, voffA);
        if (wr == 1) PG8_BAR;
        PG8_WAIT_V(2); PG8_BAR;
        PG8_STAGE(PG8_SB(1, 0), cB + kstep, voffB); PG8_STAGE(PG8_SA(1, 0), cA + kstep, voffA); PG8_STAGE(PG8_SB(1, 1), cB + hstep + kstep, voffB);
        PG8_WAIT_V(6); PG8_BAR;
    } else {
        PG8_STAGE(PG8_SB(0, 0), cB, voffB); PG8_STAGE(PG8_SA(0, 0), cA, voffA); PG8_STAGE(PG8_SB(0, 1), cB + hstep, voffB); PG8_STAGE(PG8_SA(0, 1), cA + hstep, voffA);
        if (wr == 1) PG8_BAR;
        PG8_WAIT_V(4); PG8_BAR;
        PG8_STAGE(PG8_SB(1, 0), cB + kstep, voffB); PG8_STAGE(PG8_SA(1, 0), cA + kstep, voffA); PG8_STAGE(PG8_SB(1, 1), cB + hstep + kstep, voffB);
        PG8_WAIT_V(6); PG8_BAR;
    }
    for (;;) {
        const bool has_next = S.next(ui + 1, nxt);
        const char* nA = has_next ? (const char*)g.A + (size_t)nxt.pm * tstep : cA; const char* nB = has_next ? (const char*)g.Bt + (size_t)nxt.pn * tstep : cB;
        for (int t = 0; t < nt; t += 2) {
            const bool last = (t == nt - 2);
            const char* a1 = cA + (size_t)(t + 1) * kstep;
            const char* a2 = last ? nA : cA + (size_t)(t + 2) * kstep; const char* b2 = last ? nB : cB + (size_t)(t + 2) * kstep;
            const char* a3 = a2 + kstep; const char* b3 = b2 + kstep;
            if (last && has_next) S.a_ready(nxt);
            if constexpr (SP2) {
            PG8_LDB(B0, 0, 0); PG8_LDB(B1, 0, 1); PG8_SCHED; PG8_LDA(At, 0, 0); PG8_STAGE(PG8_SA(1, 1), a1 + hstep, voffA);
            PG8_WAIT_V(8); PG8_WAIT_L(0); PG8_BAR; PG8_MMA(0, 0, At, B0); PG8_MMA(0, 1, At, B1); PG8_BAR; PG8_SCHED;
            PG8_LDA(At, 0, 1); PG8_STAGE(PG8_SB(0, 0), b2, voffB); PG8_STAGE(PG8_SB(0, 1), b2 + hstep, voffB); PG8_STAGE(PG8_SA(0, 0), a2, voffA);
            PG8_WAIT_V(8); PG8_WAIT_L(0); PG8_BAR; PG8_MMA(1, 0, At, B0); PG8_MMA(1, 1, At, B1); PG8_BAR; PG8_SCHED;
            PG8_LDB(B0, 1, 0); PG8_LDB(B1, 1, 1); PG8_SCHED; PG8_LDA(At, 1, 0); PG8_STAGE(PG8_SA(0, 1), a2 + hstep, voffA);
            PG8_WAIT_V(8); PG8_WAIT_L(0); PG8_BAR; PG8_MMA(0, 0, At, B0); PG8_MMA(0, 1, At, B1); PG8_BAR; PG8_SCHED;
            PG8_LDA(At, 1, 1); PG8_STAGE(PG8_SB(1, 0), b3, voffB); PG8_STAGE(PG8_SB(1, 1), b3 + hstep, voffB); PG8_STAGE(PG8_SA(1, 0), a3, voffA);
            PG8_WAIT_V(8); PG8_WAIT_L(0); PG8_BAR; PG8_MMA(1, 0, At, B0); PG8_MMA(1, 1, At, B1); PG8_BAR; PG8_SCHED;
            } else {
            PG8_LDB(B0, 0, 0); PG8_SCHED; PG8_LDA(At, 0, 0); PG8_STAGE(PG8_SA(1, 1), a1 + hstep, voffA);
            PG8_WAIT_L(8); PG8_BAR; PG8_WAIT_L(0); PG8_MMA(0, 0, At, B0); PG8_BAR; PG8_SCHED;
            PG8_LDB(B1, 0, 1); PG8_STAGE(PG8_SB(0, 0), b2, voffB);
            PG8_BAR; PG8_WAIT_L(0); PG8_MMA(0, 1, At, B1); PG8_BAR;
            PG8_LDA(At, 0, 1); PG8_STAGE(PG8_SA(0, 0), a2, voffA);
            PG8_BAR; PG8_WAIT_L(0); PG8_MMA(1, 0, At, B0); PG8_BAR; PG8_SCHED;
            PG8_STAGE(PG8_SB(0, 1), b2 + hstep, voffB);
            PG8_WAIT_V(6); PG8_BAR; PG8_MMA(1, 1, At, B1); PG8_BAR;
            PG8_LDB(B0, 1, 0); PG8_SCHED; PG8_LDA(At, 1, 0); PG8_STAGE(PG8_SA(0, 1), a2 + hstep, voffA);
            PG8_WAIT_L(8); PG8_BAR; PG8_WAIT_L(0); PG8_MMA(0, 0, At, B0); PG8_BAR; PG8_SCHED;
            PG8_LDB(B1, 1, 1); PG8_STAGE(PG8_SB(1, 0), b3, voffB);
            PG8_BAR; PG8_WAIT_L(0); PG8_MMA(0, 1, At, B1); PG8_BAR;
            PG8_LDA(At, 1, 1); PG8_STAGE(PG8_SA(1, 0), a3, voffA);
            PG8_BAR; PG8_WAIT_L(0); PG8_MMA(1, 0, At, B0); PG8_BAR; PG8_SCHED;
            PG8_STAGE(PG8_SB(1, 1), b3 + hstep, voffB);
            PG8_WAIT_V(6); PG8_BAR; PG8_MMA(1, 1, At, B1); PG8_BAR;
            }
        }
        if constexpr (ALIGN_EPI) { if (wr == 0) PG8_BAR; }
        if constexpr (!Epi::AFTER_DRAIN) { E(acc, cur, wr, wc, fr, fq); S.done(cur); }
        if (!has_next) break;
#pragma unroll
        for (int a = 0; a < 2; ++a)
#pragma unroll
            for (int b = 0; b < 2; ++b)
#pragma unroll
                for (int m = 0; m < 4; ++m)
#pragma unroll
                    for (int n = 0; n < 2; ++n) acc[a][b][m][n] = (f32x4){0.f, 0.f, 0.f, 0.f};
        cur = nxt; cA = nA; cB = nB; ++ui;
        if constexpr (ALIGN_EPI) { if (wr == 1) PG8_BAR; }
    }
    PG8_WAIT_V(0);
    if constexpr (!ALIGN_EPI) { if (wr == 0) PG8_BAR; }
    PG8_BAR;
    if constexpr (Epi::AFTER_DRAIN) { E.fused(acc, cur, wr, wc, fr, fq, lds, wid, lane); S.done(cur); }
#undef PG8_SA
#undef PG8_SB
#undef PG8_STAGE
#undef PG8_LDA
#undef PG8_LDB
#undef PG8_MMA
#undef PG8_WAIT_V
#undef PG8_WAIT_L
#undef PG8_BAR
#undef PG8_SCHED
}
}
using pg8::bf16_t; using pg8::bf16x8; using pg8::f32x4; using pg8::u32x4; using pg8::u32x2; using pg8::cvtpk; using pg8::RMS_EPS; using pg8::LOG2E;
typedef float f32x16 __attribute__((ext_vector_type(16)));
#define LAS __attribute__((address_space(3)))
constexpr int NTHR = 512, NWAVES = 8;
constexpr int BATCH = 2, SEQ = 8192, DM = 1024, M = BATCH * SEQ, DFF = 2816, INW = 3088;
constexpr size_t MiB = 1u << 20;
constexpr size_t WS_BAR = 0;
constexpr size_t WS_QHEAD = 15360;
constexpr size_t WS_ROWSS = 64 * 1024;
constexpr size_t WS_WIN = 2 * MiB;
constexpr size_t WS_WO = 8 * MiB;
constexpr size_t WS_WGU = 10 * MiB;
constexpr size_t WS_WD = 21 * MiB;
constexpr size_t WS_GLR = 27 * MiB;
constexpr size_t WS_DVEC = 28 * MiB;
constexpr size_t WS_XN = 32 * MiB;
constexpr size_t WS_PROJ = 64 * MiB;
constexpr size_t WS_VT = 160 * MiB;
constexpr size_t WS_GVT = 176 * MiB;
constexpr size_t WS_MIX = 192 * MiB;
constexpr size_t WS_ST = 224 * MiB;
constexpr size_t WS_END = 256 * MiB;
constexpr int LDS_BYTES = 147456;

__device__ __forceinline__ float bf2f(bf16_t v) { return __uint_as_float((unsigned)v << 16); }
__device__ __forceinline__ bf16_t f2bf(float f) { return (bf16_t)(cvtpk(f, f) & 0xffffu); }
__device__ __forceinline__ float wave_sum(float v) {
#pragma unroll
    for (int o = 1; o < 64; o <<= 1) v += __shfl_xor(v, o);
    return v;
}
__device__ __forceinline__ float wave_max(float v) {
#pragma unroll
    for (int o = 1; o < 64; o <<= 1) v = fmaxf(v, __shfl_xor(v, o));
    return v;
}
__device__ __forceinline__ int crow(int r, int hi) { return (r & 3) + 8 * (r >> 2) + 4 * hi; }
__device__ __forceinline__ int pi_row(int m) { return (m & ~12) | ((m & 4) << 1) | ((m & 8) >> 1); }
__device__ __forceinline__ bf16x8 pack8(float a0, float a1, float a2, float a3, float a4, float a5, float a6, float a7) {
    u32x4 w; w.x = cvtpk(a0, a1); w.y = cvtpk(a2, a3); w.z = cvtpk(a4, a5); w.w = cvtpk(a6, a7); return __builtin_bit_cast(bf16x8, w);
}

template <int MODE> __device__ __forceinline__ int wrow(int n) {
    if (MODE == 1) { const int pn = n >> 8, L = n & 255; return pn * 256 + ((L >> 5) & 1) * 128 + (L >> 6) * 32 + (L & 31); }
    if (MODE == 2) return (n >> 7) * 256 + (n & 127);
    if (MODE == 3) return (n >> 7) * 256 + 128 + (n & 127);
    return n;
}
template <int MODE> __device__ __forceinline__ void p0_transpose_item(const float* W, int ld, int K, int ncols, bf16_t* WT, const float* gain, LAS float* scr, int item, int lane) {
    const int nblk = ncols / 32, kb = item / nblk, nb = item % nblk, k0 = 64 * kb, n0 = 32 * nb;
    float tv[32];
#pragma unroll
    for (int i = 0; i < 32; ++i) { const int kk = 2 * i + (lane >> 5); tv[i] = W[(size_t)(k0 + kk) * ld + n0 + (lane & 31)]; }
    if (gain) {
#pragma unroll
        for (int i = 0; i < 32; ++i) tv[i] *= gain[k0 + 2 * i + (lane >> 5)];
    }
#pragma unroll
    for (int i = 0; i < 32; ++i) scr[(2 * i + (lane >> 5)) * 33 + (lane & 31)] = tv[i];
    asm volatile("s_waitcnt lgkmcnt(0)" ::: "memory");
    const int c = lane & 7;
#pragma unroll
    for (int j = 0; j < 4; ++j) { const int n = (lane >> 3) + 8 * j; const LAS float* s = scr + (8 * c) * 33 + n;
        u32x4 o; o.x = cvtpk(s[0 * 33], s[1 * 33]); o.y = cvtpk(s[2 * 33], s[3 * 33]); o.z = cvtpk(s[4 * 33], s[5 * 33]); o.w = cvtpk(s[6 * 33], s[7 * 33]);
        *(u32x4*)(WT + (size_t)wrow<MODE>(n0 + n) * K + k0 + 8 * c) = o; }
    asm volatile("s_waitcnt lgkmcnt(0)" ::: "memory");
}
struct P0Args { const float *x, *again, *w_in, *w_out, *fgain, *w_g, *w_u, *w_d; bf16_t *WinT, *WoT, *WguT, *WdT, *XN; float *glr, *rowss; };
__device__ __forceinline__ void p0_prologue(LAS unsigned char* lds, const P0Args& A, int G, int bid) {
    int tid_ = threadIdx.x; asm volatile("" : "+v"(tid_)); const int tid = tid_, lane = tid & 63, wave = __builtin_amdgcn_readfirstlane(tid >> 6);
    LAS float* scr = (LAS float*)(lds + wave * 16384);
    const int gw = bid * NWAVES + wave, NGW = G * NWAVES;
    for (int i = bid * NTHR + tid; i < M; i += G * NTHR) A.rowss[i] = 0.f;
    for (int it = gw; it < 16 * 96; it += NGW) p0_transpose_item<1>(A.w_in, INW, 1024, 3072, A.WinT, nullptr, scr, it, lane);
    __syncthreads();
    LAS float* WtT = (LAS float*)lds;
    { float wv[32];
#pragma unroll
      for (int q = 0; q < 32; ++q) { const int i = tid + NTHR * q; wv[q] = A.w_in[(size_t)(i >> 4) * INW + 3072 + (i & 15)]; }
#pragma unroll
      for (int q = 0; q < 32; ++q) { const int i = tid + NTHR * q; WtT[(i & 15) * 1024 + (i >> 4)] = wv[q]; } }
    __syncthreads();
    f32x4 gnv[4];
#pragma unroll
    for (int j = 0; j < 4; ++j) gnv[j] = ((const f32x4*)A.again)[64 * j + lane];
    for (int m = gw; m < M; m += NGW) {
        const f32x4* xr = (const f32x4*)(A.x + (size_t)m * 1024) + lane;
        f32x4 v[4]; float ss = 0.f;
#pragma unroll
        for (int j = 0; j < 4; ++j) { v[j] = xr[64 * j]; ss += (v[j][0] * v[j][0] + v[j][1] * v[j][1]) + (v[j][2] * v[j][2] + v[j][3] * v[j][3]); }
        const float rstd = rsqrtf(wave_sum(ss) * (1.0f / 1024.0f) + RMS_EPS);
        unsigned long long* o8 = (unsigned long long*)(A.XN + (size_t)m * 1024) + lane;
#pragma unroll
        for (int j = 0; j < 4; ++j) { const f32x4 g = gnv[j]; v[j] = v[j] * rstd * g;
            o8[64 * j] = (unsigned long long)cvtpk(v[j][0], v[j][1]) | ((unsigned long long)cvtpk(v[j][2], v[j][3]) << 32); }
        float p[16];
#pragma unroll
        for (int r = 0; r < 16; ++r) { float a = 0.f;
#pragma unroll
            for (int j = 0; j < 4; ++j) { const f32x4 w = *(const LAS f32x4*)(WtT + r * 1024 + 256 * j + 4 * lane); a += (v[j][0] * w[0] + v[j][1] * w[1]) + (v[j][2] * w[2] + v[j][3] * w[3]); }
            p[r] = a; if (r & 1) asm volatile("" ::: "memory"); }
#pragma unroll
        for (int i = 0; i < 8; ++i) { const bool up = lane & 1; const float send = up ? p[i] : p[i + 8], keep = up ? p[i + 8] : p[i]; p[i] = keep + __shfl_xor(send, 1); }
#pragma unroll
        for (int i = 0; i < 4; ++i) { const bool up = lane & 2; const float send = up ? p[i] : p[i + 4], keep = up ? p[i + 4] : p[i]; p[i] = keep + __shfl_xor(send, 2); }
#pragma unroll
        for (int i = 0; i < 2; ++i) { const bool up = lane & 4; const float send = up ? p[i] : p[i + 2], keep = up ? p[i + 2] : p[i]; p[i] = keep + __shfl_xor(send, 4); }
        { const bool up = lane & 8; const float send = up ? p[0] : p[1], keep = up ? p[1] : p[0]; p[0] = keep + __shfl_xor(send, 8); }
        p[0] += __shfl_xor(p[0], 16); p[0] += __shfl_xor(p[0], 32);
        if (lane < 16) { const int r = 8 * (lane & 1) + 4 * ((lane >> 1) & 1) + 2 * ((lane >> 2) & 1) + ((lane >> 3) & 1); A.glr[(size_t)m * 16 + r] = p[0]; }
    }
}

constexpr int LW_O = 16 * 32, LW_G = 16 * 88, LW_D = 44 * 32, LW_ITEMS = LW_O + 2 * LW_G + LW_D, LW_BLOCK_ITEMS = LW_ITEMS / 8;
static_assert(LW_ITEMS % 8 == 0, "late-weight pieces come in groups of eight");
__device__ __forceinline__ void late_weights_item(LAS unsigned char* lds, const P0Args& A, int bi) {
    int tid_ = threadIdx.x; asm volatile("" : "+v"(tid_)); const int lane = tid_ & 63, wave = __builtin_amdgcn_readfirstlane(tid_ >> 6);
    LAS float* scr = (LAS float*)(lds + wave * 16384);
    int r = bi * 8 + wave;
    if (r < LW_O) { p0_transpose_item<0>(A.w_out, 1024, 1024, 1024, A.WoT, nullptr, scr, r, lane); return; } r -= LW_O;
    if (r < LW_G) { p0_transpose_item<2>(A.w_g, DFF, 1024, DFF, A.WguT, A.fgain, scr, r, lane); return; } r -= LW_G;
    if (r < LW_G) { p0_transpose_item<3>(A.w_u, DFF, 1024, DFF, A.WguT, A.fgain, scr, r, lane); return; } r -= LW_G;
    p0_transpose_item<0>(A.w_d, 1024, DFF, 1024, A.WdT, nullptr, scr, r, lane);
}
constexpr int RS = 144;
constexpr int G1_GLR = 0, G1_TOT = 4096, G1_QT = 6144, G1_KT = G1_QT + 64 * RS, G1_KD = G1_KT + 64 * RS, G1_VT = G1_KD + 64 * RS;
struct GlaArgs { const bf16_t* proj; const bf16_t* gvt; const float* glr; const float* w_up; const float* b_gate; bf16_t* QT; float* OINTRA; float* ST; float* dvec; };
__device__ __forceinline__ void gla_chunk_load(const GlaArgs& A, int task, int tid, int lane, int wid, float (&g)[2], u32x4 (&v)[2], unsigned (&qv)[8], unsigned (&kv)[8]) {
    const int bh = task >> 7, c = task & 127, b = bh >> 2, h = bh & 3; const int tok0 = b * SEQ + c * 64;
#pragma unroll
    for (int i = 0; i < 2; ++i) g[i] = A.glr[(size_t)tok0 * 16 + tid + NTHR * i];
#pragma unroll
    for (int i = 0; i < 2; ++i) { const int idx = tid + NTHR * i, row = idx >> 3, ch = idx & 7; v[i] = *(const u32x4*)(A.gvt + ((size_t)(bh * 128 + row)) * SEQ + c * 64 + ch * 8); }
#pragma unroll
    for (int i = 0; i < 8; ++i) { const bf16_t* p = A.proj + (size_t)(tok0 + 8 * wid + i) * 3072 + 1536 + h * 64 + lane; qv[i] = (unsigned)p[0]; kv[i] = (unsigned)p[256]; }
}
__device__ __forceinline__ void gla_chunk_body(LAS unsigned char* lds, const GlaArgs& A, int task, int tid, int lane, int wid, const float (&g)[2], const u32x4 (&v)[2], const unsigned (&qr)[8], const unsigned (&kr)[8], const float (&wup)[16], float bias) {
    const int r32 = lane & 31, hi = lane >> 5;
    LAS float* glrS = (LAS float*)(lds + G1_GLR); LAS float* tot = (LAS float*)(lds + G1_TOT);
    {
#pragma unroll
        for (int i = 0; i < 2; ++i) glrS[tid + NTHR * i] = g[i];
#pragma unroll
        for (int i = 0; i < 2; ++i) { const int idx = tid + NTHR * i, row = idx >> 3, ch = idx & 7; *(LAS u32x4*)(lds + G1_VT + row * RS + ch * 16) = v[i]; }
        __syncthreads();
        float cum[8]; float run = 0.f;
#pragma unroll
        for (int i = 0; i < 8; ++i) { const int t = 8 * wid + i; float z = bias;
#pragma unroll
            for (int r = 0; r < 16; ++r) z += glrS[t * 16 + r] * wup[r];
            const float y = -z; const float sp = fmaxf(y, 0.f) + log1pf(__expf(-fabsf(y)));
            run -= sp * (1.0f / 16.0f); cum[i] = run; }
        tot[wid * 64 + lane] = run;
        __syncthreads();
        float prefix = 0.f, total = 0.f;
#pragma unroll
        for (int w = 0; w < 8; ++w) { const float tv = tot[w * 64 + lane]; total += tv; if (w < wid) prefix += tv; }
        float kd[8];
#pragma unroll
        for (int i = 0; i < 8; ++i) { const int t = 8 * wid + i; const float bb = prefix + cum[i]; const float qvi = __uint_as_float(qr[i] << 16), kvi = __uint_as_float(kr[i] << 16);
            const bf16_t qt = f2bf(qvi * __expf(bb)), kt = f2bf(kvi * __expf(-bb)); kd[i] = kvi * __expf(total - bb);
            *(LAS bf16_t*)(lds + G1_QT + t * RS + lane * 2) = qt; *(LAS bf16_t*)(lds + G1_KT + t * RS + lane * 2) = kt;
            A.QT[(size_t)task * 4096 + t * 64 + lane] = qt; }
        *(LAS bf16x8*)(lds + G1_KD + lane * RS + wid * 16) = pack8(kd[0], kd[1], kd[2], kd[3], kd[4], kd[5], kd[6], kd[7]);
        if (wid == 0) A.dvec[task * 64 + lane] = __expf(total);
        __syncthreads();
        const int tb = wid & 1, vb = wid >> 1;
        f32x16 o = {};
#pragma unroll
        for (int sb = 0; sb < 2; ++sb) {
            if (sb <= tb) {
                f32x16 X = {};
#pragma unroll
                for (int ks = 0; ks < 4; ++ks) {
                    const bf16x8 a = *(const LAS bf16x8*)(lds + G1_KT + (32 * sb + pi_row(r32)) * RS + (16 * ks + 8 * hi) * 2);
                    const bf16x8 bq = *(const LAS bf16x8*)(lds + G1_QT + (32 * tb + r32) * RS + (16 * ks + 8 * hi) * 2);
                    X = __builtin_amdgcn_mfma_f32_32x32x16_bf16(a, bq, X, 0, 0, 0);
                }
                if (sb == tb) {
#pragma unroll
                    for (int r = 0; r < 16; ++r) { if ((16 * (r >> 3) + (r & 7)) > r32 - 8 * hi) X[r] = 0.f; }
                }
                const bf16x8 P0 = pack8(X[0], X[1], X[2], X[3], X[4], X[5], X[6], X[7]), P1 = pack8(X[8], X[9], X[10], X[11], X[12], X[13], X[14], X[15]);
                const bf16x8 v0 = *(const LAS bf16x8*)(lds + G1_VT + (32 * vb + r32) * RS + (32 * sb + 8 * hi) * 2);
                const bf16x8 v1 = *(const LAS bf16x8*)(lds + G1_VT + (32 * vb + r32) * RS + (32 * sb + 16 + 8 * hi) * 2);
                o = __builtin_amdgcn_mfma_f32_32x32x16_bf16(P0, v0, o, 0, 0, 0);
                o = __builtin_amdgcn_mfma_f32_32x32x16_bf16(P1, v1, o, 0, 0, 0);
            }
        }
        u32x4* op = (u32x4*)((unsigned*)A.OINTRA + (size_t)task * 4096 + (tb * 4 + vb) * 512 + lane * 8);
#pragma unroll
        for (int q4 = 0; q4 < 2; ++q4) { u32x4 w; w.x = cvtpk(o[8 * q4], o[8 * q4 + 1]); w.y = cvtpk(o[8 * q4 + 2], o[8 * q4 + 3]); w.z = cvtpk(o[8 * q4 + 4], o[8 * q4 + 5]); w.w = cvtpk(o[8 * q4 + 6], o[8 * q4 + 7]); op[q4] = w; }
        f32x16 ut = {};
#pragma unroll
        for (int ks = 0; ks < 4; ++ks) {
            const bf16x8 a = *(const LAS bf16x8*)(lds + G1_VT + (32 * vb + r32) * RS + (16 * ks + 8 * hi) * 2);
            const bf16x8 bk = *(const LAS bf16x8*)(lds + G1_KD + (32 * tb + r32) * RS + (16 * ks + 8 * hi) * 2);
            ut = __builtin_amdgcn_mfma_f32_32x32x16_bf16(a, bk, ut, 0, 0, 0);
        }
        float* sp = A.ST + (size_t)task * 8192 + 32 * tb + r32;
#pragma unroll
        for (int r = 0; r < 16; ++r) sp[(32 * vb + crow(r, hi)) * 64] = ut[r];
        __syncthreads();
    }
}
__device__ __forceinline__ void gla_chunk_quad(LAS unsigned char* lds, const GlaArgs& A, int task0) {
    int tid_ = threadIdx.x; asm volatile("" : "+v"(tid_)); const int tid = tid_, lane = tid & 63, wid = __builtin_amdgcn_readfirstlane(tid >> 6);
    const int h = (task0 >> 7) & 3;
    float gA[2], gB[2], gC[2], gD[2]; u32x4 vA[2], vB[2], vC[2], vD[2]; unsigned qA[8], kA[8], qB[8], kB[8], qC[8], kC[8], qD[8], kD[8];
    gla_chunk_load(A, task0, tid, lane, wid, gA, vA, qA, kA);
    gla_chunk_load(A, task0 + 1, tid, lane, wid, gB, vB, qB, kB);
    gla_chunk_load(A, task0 + 2, tid, lane, wid, gC, vC, qC, kC);
    gla_chunk_load(A, task0 + 3, tid, lane, wid, gD, vD, qD, kD);
    float wup[16];
#pragma unroll
    for (int r = 0; r < 16; ++r) wup[r] = A.w_up[r * 256 + h * 64 + lane];
    const float bias = A.b_gate[h * 64 + lane];
    gla_chunk_body(lds, A, task0, tid, lane, wid, gA, vA, qA, kA, wup, bias);
    gla_chunk_body(lds, A, task0 + 1, tid, lane, wid, gB, vB, qB, kB, wup, bias);
    gla_chunk_body(lds, A, task0 + 2, tid, lane, wid, gC, vC, qC, kC, wup, bias);
    gla_chunk_body(lds, A, task0 + 3, tid, lane, wid, gD, vD, qD, kD, wup, bias);
}
__device__ __forceinline__ void gla_scan_phase(float* ST, const float* dvec, int G, int bid) {
    int tid_ = threadIdx.x; asm volatile("" : "+v"(tid_));
    for (int gid = bid * NTHR + tid_; gid < 65536; gid += G * NTHR) {
        const int bh = gid >> 13, e = gid & 8191, k = e & 63;
        float* sp = ST + (size_t)bh * 128 * 8192 + e; const float* dp = dvec + bh * 128 * 64 + k;
        float S = 0.f;
        for (int c0 = 0; c0 < 128; c0 += 32) {
            float u[32], d[32];
#pragma unroll
            for (int j = 0; j < 32; ++j) { u[j] = sp[(size_t)(c0 + j) * 8192]; d[j] = dp[(c0 + j) * 64]; }
#pragma unroll
            for (int j = 0; j < 32; ++j) { sp[(size_t)(c0 + j) * 8192] = S; S = d[j] * S + u[j]; }
        }
    }
}
__device__ __forceinline__ void gla_scan_item(const float* ST, bf16_t* SB, const float* dvec, int j) {
    int tid_ = threadIdx.x; asm volatile("" : "+v"(tid_));
    {
        const int bh = j >> 4, e = (j & 15) * NTHR + tid_, k = e & 63;
        const float* sp = ST + (size_t)bh * 128 * 8192 + e; bf16_t* so = SB + (size_t)bh * 128 * 8192 + e; const float* dp = dvec + bh * 128 * 64 + k;
        float S = 0.f;
        for (int c0 = 0; c0 < 128; c0 += 32) {
            float u[32], d[32];
#pragma unroll
            for (int jj = 0; jj < 32; ++jj) { u[jj] = sp[(size_t)(c0 + jj) * 8192]; d[jj] = dp[(c0 + jj) * 64]; }
#pragma unroll
            for (int jj = 0; jj < 32; ++jj) { so[(size_t)(c0 + jj) * 8192] = f2bf(S); S = d[jj] * S + u[jj]; }
        }
    }
}
__device__ __forceinline__ void item_done(unsigned* cnt) {
    if (cnt != nullptr) asm volatile("s_waitcnt vmcnt(0)" ::: "memory");
    __builtin_amdgcn_s_barrier();
    if (threadIdx.x == 0 && cnt != nullptr) { __builtin_amdgcn_fence(__ATOMIC_RELEASE, "agent"); asm volatile("s_waitcnt vmcnt(0)" ::: "memory"); __hip_atomic_fetch_add(cnt, 1u, __ATOMIC_RELAXED, __HIP_MEMORY_SCOPE_AGENT); }
}
__device__ __forceinline__ void item_wait(unsigned* cnt, unsigned want) {
    if (threadIdx.x == 0 && cnt != nullptr) { unsigned spn = 0; while (__hip_atomic_load(cnt, __ATOMIC_RELAXED, __HIP_MEMORY_SCOPE_AGENT) < want) { __builtin_amdgcn_s_sleep(2); if (++spn > (1u << 16)) break; }
        __builtin_amdgcn_fence(__ATOMIC_ACQUIRE, "agent"); asm volatile("s_waitcnt vmcnt(0)" ::: "memory"); }
    __syncthreads();
}
struct Gla3Args { const bf16_t* proj; const bf16_t* QT; const float* OINTRA; const bf16_t* SB; const float* ggain; bf16_t* mixed; };
__device__ __forceinline__ void gla_out_task(const Gla3Args& A, int wt) {
    int tid_ = threadIdx.x; asm volatile("" : "+v"(tid_)); const int tid = tid_, lane = tid & 63, r32 = lane & 31, hi = lane >> 5;
    {
        const int task = wt >> 1, tb = wt & 1, bh = task >> 7, c = task & 127, b = bh >> 2, h = bh & 3; const int tok0 = b * SEQ + c * 64 + 32 * tb;
        const bf16_t* grow = A.proj + (size_t)tok0 * 3072 + 2560 + h * 128; bf16_t* mrow = A.mixed + (size_t)tok0 * 1024 + 512 + h * 128;
        unsigned goff = (unsigned)(4 * hi * 3072 + r32), moff = (unsigned)(4 * hi * 1024 + r32); asm volatile("" : "+v"(goff), "+v"(moff));
        float ggv[4];
#pragma unroll
        for (int vb = 0; vb < 4; ++vb) ggv[vb] = A.ggain[32 * vb + r32];
        bf16x8 qa[4];
#pragma unroll
        for (int ks = 0; ks < 4; ++ks) qa[ks] = *(const bf16x8*)(A.QT + (size_t)task * 4096 + (32 * tb + r32) * 64 + 16 * ks + 8 * hi);
        f32x16 acc[4];
        bf16x8 sfA[4];
#define G3_SLOAD(DST, VB) do { _Pragma("unroll") for (int ks_ = 0; ks_ < 4; ++ks_) DST[ks_] = *(const bf16x8*)(A.SB + (size_t)task * 8192 + (32 * (VB) + r32) * 64 + 16 * ks_ + 8 * hi); } while (0)
#define G3_MMA(SRC, VB) do { _Pragma("unroll") for (int ks_ = 0; ks_ < 4; ++ks_) acc[VB] = __builtin_amdgcn_mfma_f32_32x32x16_bf16(qa[ks_], SRC[ks_], acc[VB], 0, 0, 0); } while (0)
#pragma unroll
        for (int vb = 0; vb < 4; ++vb) {
            const u32x4* op = (const u32x4*)((const unsigned*)A.OINTRA + (size_t)task * 4096 + (tb * 4 + vb) * 512 + lane * 8);
#pragma unroll
            for (int q4 = 0; q4 < 2; ++q4) { const u32x4 t4 = op[q4];
                acc[vb][8 * q4] = __uint_as_float(t4.x << 16); acc[vb][8 * q4 + 1] = __uint_as_float(t4.x & 0xffff0000u); acc[vb][8 * q4 + 2] = __uint_as_float(t4.y << 16); acc[vb][8 * q4 + 3] = __uint_as_float(t4.y & 0xffff0000u);
                acc[vb][8 * q4 + 4] = __uint_as_float(t4.z << 16); acc[vb][8 * q4 + 5] = __uint_as_float(t4.z & 0xffff0000u); acc[vb][8 * q4 + 6] = __uint_as_float(t4.w << 16); acc[vb][8 * q4 + 7] = __uint_as_float(t4.w & 0xffff0000u); }
        }
#pragma unroll
        for (int vb = 0; vb < 4; ++vb) { G3_SLOAD(sfA, vb); __builtin_amdgcn_sched_barrier(0); G3_MMA(sfA, vb); __builtin_amdgcn_sched_barrier(0); }
#undef G3_SLOAD
#undef G3_MMA
        bf16_t gt[4][16];
#pragma unroll
        for (int vb = 0; vb < 4; ++vb)
#pragma unroll
            for (int r = 0; r < 16; ++r) gt[vb][r] = grow[goff + (unsigned)(((r & 3) + 8 * (r >> 2)) * 3072 + 32 * vb)];
        float rstd[16];
#pragma unroll
        for (int r = 0; r < 16; ++r) { float ss = 0.f;
#pragma unroll
            for (int vb = 0; vb < 4; ++vb) ss += acc[vb][r] * acc[vb][r];
            rstd[r] = ss; }
#pragma unroll
        for (int o = 1; o < 32; o <<= 1) {
#pragma unroll
            for (int r = 0; r < 16; ++r) rstd[r] += __shfl_xor(rstd[r], o);
            __builtin_amdgcn_sched_barrier(0); }
#pragma unroll
        for (int r = 0; r < 16; ++r) rstd[r] = rsqrtf(rstd[r] * (1.0f / 128.0f) + RMS_EPS);
#pragma unroll
        for (int vb = 0; vb < 4; ++vb) { const float gg = ggv[vb];
#pragma unroll
            for (int r = 0; r < 16; ++r) { const int rr = (r & 3) + 8 * (r >> 2);
                const float gate = bf2f(gt[vb][r]);
                const float sg = gate * __builtin_amdgcn_rcpf(1.0f + __builtin_amdgcn_exp2f(-gate * LOG2E));
                mrow[moff + (unsigned)(rr * 1024 + 32 * vb)] = f2bf(acc[vb][r] * rstd[r] * gg * sg); } }
    }
}
constexpr int AT_K = 0, AT_V = 2 * 64 * RS, AT_STAGE = AT_V + 128 * RS;
constexpr int AT_WSF = 65536;
struct AttnArgs { const bf16_t* proj; const bf16_t* vt; bf16_t* mixed; const float *qg, *kg, *lq1, *lk1, *lq2, *lk2, *dgain; float* parto; float* partl; };
__device__ __forceinline__ int attn_kt0(int h, int qb, float TH) { const float slope2 = exp2f(-2.0f * (float)(h + 1)) * LOG2E; const float v = floorf(((float)(128 * qb - 63) - TH / slope2) * (1.0f / 64.0f)) + 1.0f; return v > 0.f ? (int)v : 0; }
constexpr int SEGT = 64;
__device__ __forceinline__ bool attn_split(int h, int qb, int nt_eff) { return h >= 2 && qb >= 32 && nt_eff > SEGT; }
__device__ __forceinline__ int attn_slot(int b, int h, int qb) { return (b * 2 + (h - 2)) * 32 + (qb - 32); }
__device__ __forceinline__ bool attn_item(LAS unsigned char* lds, const AttnArgs& A, int it, float lam, float M2) {
    int tid_ = threadIdx.x; asm volatile("" : "+v"(tid_)); const int tid = tid_, lane = tid & 63, wid = __builtin_amdgcn_readfirstlane(tid >> 6), r32 = lane & 31, hi = lane >> 5;
    const int g = wid >> 2, w = wid & 3;
    int qb, bh, seg;
    if (it < 384) { qb = 63 - it / 12; const int j = it % 12; if (j < 8) { bh = j; seg = 0; } else { bh = ((j - 8) >> 1) * 4 + 2 + ((j - 8) & 1); seg = 1; } }
    else { const int i2 = it - 384; qb = 31 - (i2 >> 3); bh = i2 & 7; seg = 0; }
    const int b = bh >> 2, h = bh & 3;
    const float TH = 2.0f * M2 + 53.0f;
    const int ntile_all = 2 * qb + 2, kt0 = attn_kt0(h, qb, TH), nt_eff = ntile_all - kt0;
    const bool split = attn_split(h, qb, nt_eff);
    int kt_begin = kt0, kt_end = ntile_all;
    if (split) { const int half = nt_eff >> 1; if (seg == 0) kt_end = kt0 + half; else kt_begin = kt0 + half; }
    else if (seg == 1) return false;
    int kgo[2], klo[2], vgo[2], vlo[2];
#pragma unroll
    for (int i = 0; i < 2; ++i) { const int idx = tid + NTHR * i; const int krow = idx >> 4, kch = idx & 15; kgo[i] = krow * 3072 + kch * 8; klo[i] = AT_K + (kch >> 3) * (64 * RS) + krow * RS + (kch & 7) * 16;
        const int vrow = idx >> 3, vch = idx & 7; vgo[i] = vrow * SEQ + vch * 8; vlo[i] = AT_V + vrow * RS + vch * 16; }
    {
        const float slope2 = exp2f(-2.0f * (float)(h + 1)) * LOG2E;
        const bf16_t* Kg = A.proj + (size_t)b * SEQ * 3072 + 512 + h * 128;
        const bf16_t* Vg = A.vt + (size_t)bh * 128 * SEQ;
        {
            const int q0 = qb * 128;
            const int qpos = q0 + 32 * w + r32;
            bf16x8 qf[4];
#pragma unroll
            for (int ds = 0; ds < 4; ++ds) qf[ds] = *(const bf16x8*)(A.proj + ((size_t)b * SEQ + qpos) * 3072 + h * 128 + g * 64 + 16 * ds + 8 * hi);
            u32x4 kr[2], vr[2];
#pragma unroll
            for (int i = 0; i < 2; ++i) { kr[i] = *(const u32x4*)(Kg + (size_t)(64 * kt_begin) * 3072 + kgo[i]); vr[i] = *(const u32x4*)(Vg + 64 * kt_begin + vgo[i]); }
#pragma unroll
            for (int i = 0; i < 2; ++i) { *(LAS u32x4*)(lds + klo[i]) = kr[i]; *(LAS u32x4*)(lds + vlo[i]) = vr[i]; }
            __syncthreads();
            f32x16 O[4]; O[0] = f32x16{}; O[1] = f32x16{}; O[2] = f32x16{}; O[3] = f32x16{};
            float l = 0.f;
            float cr8[8];
#pragma unroll
            for (int j = 0; j < 8; ++j) cr8[j] = -slope2 * (float)(qpos - (8 * hi + j)) - M2;
            for (int t = kt_begin; t < kt_end; ++t) {
                const int k0 = 64 * t; const bool more = t + 1 < kt_end;
                if (more) {
#pragma unroll
                    for (int i = 0; i < 2; ++i) { kr[i] = *(const u32x4*)(Kg + (size_t)(k0 + 64) * 3072 + kgo[i]); vr[i] = *(const u32x4*)(Vg + (k0 + 64) + vgo[i]); }
                }
                const LAS unsigned char* sp = lds + ((t - kt_begin) & 1) * AT_STAGE;
                if (k0 <= q0 + 32 * w + 31) {
                    bf16x8 kf[8];
#pragma unroll
                    for (int blk = 0; blk < 2; ++blk)
#pragma unroll
                        for (int ds = 0; ds < 4; ++ds) kf[blk * 4 + ds] = *(const LAS bf16x8*)(sp + AT_K + g * (64 * RS) + (32 * blk + pi_row(r32)) * RS + (16 * ds + 8 * hi) * 2);
                    __builtin_amdgcn_sched_barrier(0);
                    f32x16 S[2];
#pragma unroll
                    for (int blk = 0; blk < 2; ++blk) {
                        const float off0 = slope2 * (float)(k0 + 32 * blk), off1 = slope2 * (float)(k0 + 32 * blk + 16);
#pragma unroll
                        for (int r = 0; r < 16; ++r) S[blk][r] = cr8[r & 7] + ((r >> 3) ? off1 : off0);
                    }
#pragma unroll
                    for (int ds = 0; ds < 4; ++ds)
#pragma unroll
                        for (int blk = 0; blk < 2; ++blk) S[blk] = __builtin_amdgcn_mfma_f32_32x32x16_bf16(kf[blk * 4 + ds], qf[ds], S[blk], 0, 0, 0);
                    bf16x8 vfA[4], vfB[4];
#pragma unroll
                    for (int ks = 0; ks < 4; ++ks) vfA[ks] = *(const LAS bf16x8*)(sp + AT_V + r32 * RS + (16 * ks + 8 * hi) * 2);
                    __builtin_amdgcn_sched_barrier(0);
                    const bool needmask = k0 + 63 > q0 + 32 * w;
                    const int dlim = qpos - k0 - 8 * hi;
                    float ls = 0.f;
                    if (needmask) {
#pragma unroll
                        for (int blk = 0; blk < 2; ++blk)
#pragma unroll
                            for (int r = 0; r < 16; ++r) { float pv = __builtin_amdgcn_exp2f(S[blk][r]);
                                if ((32 * blk + 16 * (r >> 3) + (r & 7)) > dlim) pv = 0.f;
                                S[blk][r] = pv; ls += pv; }
                    } else {
                        float ls1 = 0.f;
#pragma unroll
                        for (int blk = 0; blk < 2; ++blk)
#pragma unroll
                            for (int r = 0; r < 16; r += 2) { const float p0 = __builtin_amdgcn_exp2f(S[blk][r]), p1 = __builtin_amdgcn_exp2f(S[blk][r + 1]); S[blk][r] = p0; S[blk][r + 1] = p1; ls += p0; ls1 += p1; }
                        ls += ls1;
                    }
                    l += ls;
                    bf16x8 P[4];
#pragma unroll
                    for (int blk = 0; blk < 2; ++blk) { P[2 * blk] = pack8(S[blk][0], S[blk][1], S[blk][2], S[blk][3], S[blk][4], S[blk][5], S[blk][6], S[blk][7]);
                        P[2 * blk + 1] = pack8(S[blk][8], S[blk][9], S[blk][10], S[blk][11], S[blk][12], S[blk][13], S[blk][14], S[blk][15]); }
#pragma unroll
                    for (int vb = 0; vb < 4; ++vb) {
                        if (vb < 3) {
#pragma unroll
                            for (int ks = 0; ks < 4; ++ks) vfB[ks] = *(const LAS bf16x8*)(sp + AT_V + (32 * (vb + 1) + r32) * RS + (16 * ks + 8 * hi) * 2);
                        }
                        __builtin_amdgcn_sched_barrier(0);
#pragma unroll
                        for (int ks = 0; ks < 4; ++ks) O[vb] = __builtin_amdgcn_mfma_f32_32x32x16_bf16(P[ks], vfA[ks], O[vb], 0, 0, 0);
                        __builtin_amdgcn_sched_barrier(0);
#pragma unroll
                        for (int ks = 0; ks < 4; ++ks) vfA[ks] = vfB[ks];
                    }
                }
                if (more) { LAS unsigned char* dp = lds + ((t + 1 - kt_begin) & 1) * AT_STAGE;
#pragma unroll
                    for (int i = 0; i < 2; ++i) { *(LAS u32x4*)(dp + klo[i]) = kr[i]; *(LAS u32x4*)(dp + vlo[i]) = vr[i]; } }
                __syncthreads();
            }
            l += __shfl_xor(l, 32);
            if (split) {
                const int slot = attn_slot(b, h, qb); const size_t pidx = (size_t)((slot * 2 + seg) * 2 + g) * 4 + w;
                float* po = A.parto + pidx * 4096 + lane;
#pragma unroll
                for (int vb = 0; vb < 4; ++vb)
#pragma unroll
                    for (int r = 0; r < 16; ++r) po[(vb * 16 + r) * 64] = O[vb][r];
                if (hi == 0) A.partl[pidx * 32 + r32] = l;
                return true;
            }
            float dgv[4];
#pragma unroll
            for (int vb = 0; vb < 4; ++vb) dgv[vb] = A.dgain[32 * vb + r32] * 0.8f;
            LAS float* wsf = (LAS float*)(lds + AT_WSF) + wid * 32;
            if (hi == 0) wsf[r32] = 1.0f / l;
            asm volatile("s_waitcnt lgkmcnt(0)" ::: "memory");
            float rl[16];
#pragma unroll
            for (int r = 0; r < 16; ++r) rl[r] = wsf[crow(r, hi)];
            LAS float* X = (LAS float*)lds + (size_t)w * 64 * 64 + lane;
            if (g == 1) {
#pragma unroll
                for (int vb = 0; vb < 4; ++vb)
#pragma unroll
                    for (int r = 0; r < 16; ++r) X[(vb * 16 + r) * 64] = lam * O[vb][r] * rl[r];
            }
            __syncthreads();
            if (g == 0) {
                float rstd[16];
#pragma unroll
                for (int r = 0; r < 16; ++r) { float ss = 0.f;
#pragma unroll
                    for (int vb = 0; vb < 4; ++vb) { const float o = O[vb][r] * rl[r] - X[(vb * 16 + r) * 64]; O[vb][r] = o; ss += o * o; }
                    rstd[r] = ss; }
#pragma unroll
                for (int o = 1; o < 32; o <<= 1) {
#pragma unroll
                    for (int r = 0; r < 16; ++r) rstd[r] += __shfl_xor(rstd[r], o);
                    __builtin_amdgcn_sched_barrier(0); }
#pragma unroll
                for (int r = 0; r < 16; ++r) rstd[r] = rsqrtf(rstd[r] * (1.0f / 128.0f) + RMS_EPS);
                bf16_t* mrow = A.mixed + ((size_t)b * SEQ + q0 + 32 * w) * 1024 + h * 128;
                unsigned loff = (unsigned)(4 * hi * 1024 + r32); asm volatile("" : "+v"(loff));
#pragma unroll
                for (int vb = 0; vb < 4; ++vb) { const float dg = dgv[vb];
#pragma unroll
                    for (int r = 0; r < 16; ++r) mrow[loff + (unsigned)(((r & 3) + 8 * (r >> 2)) * 1024 + 32 * vb)] = f2bf(O[vb][r] * rstd[r] * dg); }
            }
            __syncthreads();
        }
    }
    return false;
}
__device__ __forceinline__ void attn_finalize(const AttnArgs& A, int wt, float lam, float M2) {
    int tid_ = threadIdx.x; asm volatile("" : "+v"(tid_)); const int lane = tid_ & 63, r32 = lane & 31, hi = lane >> 5;
    const int slot = wt >> 2, w = wt & 3; const int b = slot >> 6, h = 2 + ((slot >> 5) & 1), qb = 32 + (slot & 31);
    const float TH = 2.0f * M2 + 53.0f; const int nt_eff = 2 * qb + 2 - attn_kt0(h, qb, TH);
    if (!attn_split(h, qb, nt_eff)) return;
    float rl[2][16];
#pragma unroll
    for (int g = 0; g < 2; ++g)
#pragma unroll
        for (int r = 0; r < 16; ++r) { const int q = crow(r, hi); rl[g][r] = 1.0f / (A.partl[((size_t)((slot * 2 + 0) * 2 + g) * 4 + w) * 32 + q] + A.partl[((size_t)((slot * 2 + 1) * 2 + g) * 4 + w) * 32 + q]); }
    float dgv[4];
#pragma unroll
    for (int vb = 0; vb < 4; ++vb) dgv[vb] = A.dgain[32 * vb + r32];
    float o[4][16]; float rstd[16];
#pragma unroll
    for (int r = 0; r < 16; ++r) { float ss = 0.f;
#pragma unroll
        for (int vb = 0; vb < 4; ++vb) { const int e = (vb * 16 + r) * 64 + lane;
            const float o0 = A.parto[((size_t)((slot * 2 + 0) * 2 + 0) * 4 + w) * 4096 + e] + A.parto[((size_t)((slot * 2 + 1) * 2 + 0) * 4 + w) * 4096 + e];
            const float o1 = A.parto[((size_t)((slot * 2 + 0) * 2 + 1) * 4 + w) * 4096 + e] + A.parto[((size_t)((slot * 2 + 1) * 2 + 1) * 4 + w) * 4096 + e];
            const float v = o0 * rl[0][r] - lam * o1 * rl[1][r]; o[vb][r] = v; ss += v * v; }
        rstd[r] = ss; }
#pragma unroll
    for (int x = 1; x < 32; x <<= 1) {
#pragma unroll
        for (int r = 0; r < 16; ++r) rstd[r] += __shfl_xor(rstd[r], x);
        __builtin_amdgcn_sched_barrier(0); }
#pragma unroll
    for (int r = 0; r < 16; ++r) rstd[r] = rsqrtf(rstd[r] * (1.0f / 128.0f) + RMS_EPS);
    bf16_t* mrow = A.mixed + ((size_t)b * SEQ + qb * 128 + 32 * w) * 1024 + h * 128;
    unsigned loff = (unsigned)(4 * hi * 1024 + r32); asm volatile("" : "+v"(loff));
#pragma unroll
    for (int vb = 0; vb < 4; ++vb) { const float dg = dgv[vb] * 0.8f;
#pragma unroll
        for (int r = 0; r < 16; ++r) mrow[loff + (unsigned)(((r & 3) + 8 * (r >> 2)) * 1024 + 32 * vb)] = f2bf(o[vb][r] * rstd[r] * dg); }
}
__device__ __forceinline__ void attn_consts(const AttnArgs& A, float& lam, float& M2) {
    int tid_ = threadIdx.x; asm volatile("" : "+v"(tid_)); const int lane = tid_ & 63;
    lam = __expf(wave_sum(A.lq1[lane] * A.lk1[lane])) - __expf(wave_sum(A.lq2[lane] * A.lk2[lane])) + 0.2f;
    M2 = 8.0f * wave_max(fabsf(A.qg[lane])) * wave_max(fabsf(A.kg[lane])) * LOG2E;
    lam = __uint_as_float(__builtin_amdgcn_readfirstlane(__float_as_uint(lam))); M2 = __uint_as_float(__builtin_amdgcn_readfirstlane(__float_as_uint(M2)));
}
#define XB_TMO      128
#define XB_XCNT(j)  (256  + 64 * (j))
#define XB_XSUB(j)  (1280 + 64 * (j))
#define XB_XGEN(j)  (2304 + 64 * (j))
#define XB_TOP      3328
#define XB_TOPGEN   3392
#define XCD_BAR_WORDS 3456
#define XB_SPIN_CAP (1u << 18)

__device__ __forceinline__ unsigned xb_ld(unsigned* p)              { return __hip_atomic_load(p, __ATOMIC_RELAXED, __HIP_MEMORY_SCOPE_AGENT); }
__device__ __forceinline__ unsigned xb_add(unsigned* p, unsigned v) { return __hip_atomic_fetch_add(p, v, __ATOMIC_RELAXED, __HIP_MEMORY_SCOPE_AGENT); }
__device__ __forceinline__ unsigned xb_xcc_id() { return (unsigned)__builtin_amdgcn_s_getreg((3 << 11) | 20) & 0xFu; }
#define XB_SPIN(cond, bar) do { unsigned _sp = 0; while (cond) { __builtin_amdgcn_s_sleep(1); \
    if ((++_sp & 255u) == 0u) { if (xb_ld(&(bar)[XB_TMO])) break; if (_sp > XB_SPIN_CAP) { atomicAdd(&(bar)[XB_TMO], 1u); break; } } } } while (0)

struct XcdBarrier {
    unsigned* bar; unsigned x;
    volatile LAS unsigned* st;
};

__device__ __forceinline__ XcdBarrier xcd_barrier_post(unsigned* bar, volatile LAS unsigned* st) {
    XcdBarrier b; b.bar = bar; b.x = xb_xcc_id(); b.st = st;
    if (threadIdx.x == 0) (void)xb_add(&bar[XB_XCNT(b.x)], 1u);
    return b;
}
__device__ __forceinline__ void xcd_barrier_complete(unsigned* bar, unsigned x, unsigned& nloc, unsigned& nx) {
    const unsigned G = gridDim.x * gridDim.y * gridDim.z;
    unsigned sum, cnt, mine, sp = 0u;
    for (;;) {
        sum = 0u; cnt = 0u; mine = 0u;
#pragma unroll
        for (unsigned j = 0; j < 16; ++j) { const unsigned c = xb_ld(&bar[XB_XCNT(j)]); sum += c; cnt += (c > 0u) ? 1u : 0u; mine = (j == x) ? c : mine; }
        if (sum == G) break;
        __builtin_amdgcn_s_sleep(1);
        if ((++sp & 255u) == 0u) { if (xb_ld(&bar[XB_TMO])) break; if (sp > XB_SPIN_CAP) { atomicAdd(&bar[XB_TMO], 1u); break; } }
    }
    nloc = mine > 0u ? mine : 1u; nx = cnt > 0u ? cnt : 1u;
}

__device__ __forceinline__ void xcd_barrier(const XcdBarrier& b) {
    asm volatile("s_waitcnt vmcnt(0)" ::: "memory");
    __syncthreads();
    if (threadIdx.x == 0) {
        unsigned* bar = b.bar;
        __builtin_amdgcn_s_waitcnt(0);
        unsigned nloc = b.st[0], nx = b.st[1];
        if (nloc == 0u) { xcd_barrier_complete(bar, b.x, nloc, nx); b.st[0] = nloc; b.st[1] = nx; }
        const unsigned old = xb_add(&bar[XB_XSUB(b.x)], 1u);
        const unsigned gen = old / nloc;
        if (old + 1u == (gen + 1u) * nloc) {
            __builtin_amdgcn_fence(__ATOMIC_RELEASE, "agent");
            asm volatile("s_waitcnt vmcnt(0)" ::: "memory");
            const unsigned og = xb_add(&bar[XB_TOP], 1u);
            const unsigned tg = og / nx;
            if (og + 1u == (tg + 1u) * nx) xb_add(&bar[XB_TOPGEN], 1u);
            else XB_SPIN(xb_ld(&bar[XB_TOPGEN]) == tg, bar);
            __builtin_amdgcn_fence(__ATOMIC_ACQUIRE, "agent");
            xb_add(&bar[XB_XGEN(b.x)], 1u);
            asm volatile("s_waitcnt vmcnt(0)" ::: "memory");
        } else {
            XB_SPIN(xb_ld(&bar[XB_XGEN(b.x)]) == gen, bar);
            __builtin_amdgcn_fence(__ATOMIC_ACQUIRE, "agent");
            asm volatile("s_waitcnt vmcnt(0)" ::: "memory");
        }
    }
    __syncthreads();
}

constexpr int MISC_OFF = 131072 + 320;
#ifndef MK_N_LAUNCHES
#define MK_N_LAUNCHES 1
#endif
constexpr int NPHASE = 9;
struct Args { const float* in[18]; float* out; unsigned char* ws; int ph_lo, ph_hi; };
__global__ void __launch_bounds__(NTHR, 2) fwd_megakernel(Args a) {
    extern __shared__ __attribute__((aligned(16))) unsigned char lds_raw[];
    LAS unsigned char* lds = (LAS unsigned char*)lds_raw;
    cg::grid_group grid = cg::this_grid();
    const int G = gridDim.x, bid = blockIdx.x;
    unsigned char* ws = a.ws;
    volatile LAS unsigned* MISC = (volatile LAS unsigned*)(lds + MISC_OFF);
    if (threadIdx.x < 32) MISC[threadIdx.x] = 0u;
    __syncthreads();
    XcdBarrier bar = xcd_barrier_post((unsigned*)(ws + WS_BAR), MISC + 8);
    if (a.ph_lo < 0) grid.sync();
    const float* x = a.in[0];
    bf16_t* WinT = (bf16_t*)(ws + WS_WIN); bf16_t* WoT = (bf16_t*)(ws + WS_WO); bf16_t* WguT = (bf16_t*)(ws + WS_WGU); bf16_t* WdT = (bf16_t*)(ws + WS_WD);
    float* glr = (float*)(ws + WS_GLR); float* dvec = (float*)(ws + WS_DVEC); float* rowss = (float*)(ws + WS_ROWSS);
    bf16_t* XN = (bf16_t*)(ws + WS_XN); bf16_t* PROJ = (bf16_t*)(ws + WS_PROJ); bf16_t* VT = (bf16_t*)(ws + WS_VT); bf16_t* GVT = (bf16_t*)(ws + WS_GVT);
    bf16_t* MIX = (bf16_t*)(ws + WS_MIX); float* ST = (float*)(ws + WS_ST);
    float* OINTRA = a.out; bf16_t* SB = (bf16_t*)((unsigned char*)a.out + 16 * MiB); bf16_t* QT = (bf16_t*)((unsigned char*)a.out + 32 * MiB);
    bf16_t* HB = XN; bf16_t* HID = PROJ;
    float* PARTO = (float*)(ws + WS_XN); float* PARTL = (float*)((unsigned char*)a.out + 40 * MiB);
    const int lo = a.ph_lo, hi = a.ph_hi;
#define IN(k) (lo <= (k) && (k) < hi)
#ifndef REPEAT_MASK
#define REPEAT_MASK 0
#endif
#define REP(k) (((REPEAT_MASK >> (k)) & 1) ? 2 : 1)
#define SEAM(k) do { if (IN(k) && IN((k) + 1)) xcd_barrier(bar); } while (0)
    if (IN(0)) for (int rep_ = 0; rep_ < REP(0); ++rep_) { P0Args P{x, a.in[1], a.in[2], a.in[13], a.in[14], a.in[15], a.in[16], a.in[17], WinT, WoT, WguT, WdT, XN, glr, rowss}; p0_prologue(lds, P, G, bid); }
    SEAM(0);
    if (IN(1)) for (int rep_ = 0; rep_ < REP(1); ++rep_) { pg8::Gemm g{XN, WinT, M, 3072, 1024}; pg8::StaticOrder S; S.init(M, 3072, G, bid);
        pg8::EpiInProj E{PROJ, VT, GVT, a.in[3], a.in[4]};
        pg8::gemm_phase<pg8::EpiInProj, pg8::StaticOrder, true, true>(lds, g, S, E); }
    SEAM(1);
    if (IN(2)) { GlaArgs GA{PROJ, GVT, glr, a.in[10], a.in[11], QT, OINTRA, ST, dvec}; Gla3Args GB{PROJ, QT, OINTRA, SB, a.in[12], MIX};
        AttnArgs AA{PROJ, VT, MIX, a.in[3], a.in[4], a.in[5], a.in[6], a.in[7], a.in[8], a.in[9], PARTO, PARTL};
        P0Args PW{x, a.in[1], a.in[2], a.in[13], a.in[14], a.in[15], a.in[16], a.in[17], WinT, WoT, WguT, WdT, XN, glr, rowss};
        float lam, M2; attn_consts(AA, lam, M2);
        unsigned* qhead = (unsigned*)(ws + WS_QHEAD); unsigned* g1done = qhead + 64; unsigned* scandone = qhead + 128; unsigned* splitdone = qhead + 192;
        const int wid_ = __builtin_amdgcn_readfirstlane(threadIdx.x >> 6);
        int nsplit;
        { const float TH = 2.0f * M2 + 53.0f; const int l_ = threadIdx.x & 63; float sp_ = 0.f;
#pragma unroll
          for (int q_ = 0; q_ < 2; ++q_) { const int t_ = l_ + 64 * q_; const int h_ = 2 + ((t_ >> 5) & 1), qb_ = 32 + (t_ & 31); sp_ += attn_split(h_, qb_, 2 * qb_ + 2 - attn_kt0(h_, qb_, TH)) ? 1.f : 0.f; }
          nsplit = __builtin_amdgcn_readfirstlane((int)(wave_sum(sp_) + 0.5f)); }
        constexpr int Q_A1 = 256, Q_SC = Q_A1 + 256, Q_A2 = Q_SC + 128, Q_FN = Q_A2 + 384, Q_G3 = Q_FN + 64, Q_LW = Q_G3 + 256, Q_END = Q_LW + LW_BLOCK_ITEMS;
        unsigned nxt_ = 0u;
        if (threadIdx.x == 0) nxt_ = __hip_atomic_fetch_add(qhead, 1u, __ATOMIC_RELAXED, __HIP_MEMORY_SCOPE_AGENT);
        for (;;) {
            if (threadIdx.x == 0) MISC[0] = nxt_;
            __syncthreads();
            const int it = __builtin_amdgcn_readfirstlane((int)MISC[0]);
            __syncthreads();
            if (it >= Q_END) break;
            const int ty = it < Q_A1 ? 0 : it < Q_SC ? 1 : it < Q_A2 ? 2 : it < Q_FN ? 1 : it < Q_G3 ? 3 : it < Q_LW ? 4 : 5;
            unsigned* wcnt = ty == 2 ? g1done : ty == 3 ? splitdone : ty == 4 ? scandone : nullptr;
            const unsigned want = ty == 2 ? 256u : ty == 3 ? 2u * (unsigned)nsplit : 128u;
            item_wait(wcnt, want);
            unsigned* dcnt = nullptr;
            if (ty == 0) { gla_chunk_quad(lds, GA, 4 * it); dcnt = g1done; }
            else if (ty == 1) { const int ai = it < Q_SC ? it - Q_A1 : it - Q_A2 + 256; if (attn_item(lds, AA, ai, lam, M2)) dcnt = splitdone; }
            else if (ty == 2) { gla_scan_item(ST, SB, dvec, it - Q_SC); dcnt = scandone; }
            else if (ty == 3) attn_finalize(AA, (it - Q_FN) * NWAVES + wid_, lam, M2);
            else if (ty == 4) gla_out_task(GB, (it - Q_G3) * NWAVES + wid_);
            else late_weights_item(lds, PW, it - Q_LW);
            if (threadIdx.x == 0) nxt_ = __hip_atomic_fetch_add(qhead, 1u, __ATOMIC_RELAXED, __HIP_MEMORY_SCOPE_AGENT);
            item_done(dcnt);
        }
    }
    SEAM(2);
    if (IN(6)) for (int rep_ = 0; rep_ < REP(6); ++rep_) { pg8::Gemm g{MIX, WoT, M, 1024, 1024}; pg8::StaticOrder S; S.init(M, 1024, G, bid);
        pg8::EpiOut E{x, a.out, HB, rowss};
        pg8::gemm_phase<pg8::EpiOut, pg8::StaticOrder, false, true>(lds, g, S, E); }
    SEAM(6);
    if (IN(7)) for (int rep_ = 0; rep_ < REP(7); ++rep_) { pg8::Gemm g{HB, WguT, M, 2 * DFF, 1024}; pg8::StaticOrder S; S.init(M, 2 * DFF, G, bid);
        pg8::EpiSwiGLU E{HID, rowss};
        pg8::gemm_phase<pg8::EpiSwiGLU, pg8::StaticOrder, true, true>(lds, g, S, E); }
    SEAM(7);
    if (IN(8)) for (int rep_ = 0; rep_ < REP(8); ++rep_) { pg8::Gemm g{HID, WdT, M, 1024, DFF}; pg8::StaticOrder S; S.init(M, 1024, G, bid);
        pg8::EpiDown E{a.out, HB};
        pg8::gemm_phase<pg8::EpiDown, pg8::StaticOrder, false, true>(lds, g, S, E); }
#undef IN
#undef SEAM
}

extern "C" void kernel_launch(void* const* d_in, const int* in_sizes, int n_in, void* d_out, int out_size, void* d_ws, size_t ws_size, hipStream_t stream) {
    static int grid = 0;
    if (grid == 0) {
        if (n_in != 18 || out_size != M * DM || ws_size < WS_END) { fprintf(stderr, "kernel_launch: unexpected shapes (n_in %d, out %d, ws %zu)\n", n_in, out_size, ws_size); grid = -1; return; }
        int dev = 0, cus = 0, per_cu = 0;
        hipGetDevice(&dev); hipDeviceGetAttribute(&cus, hipDeviceAttributeMultiprocessorCount, dev);
        hipFuncSetAttribute((const void*)fwd_megakernel, hipFuncAttributeMaxDynamicSharedMemorySize, LDS_BYTES);
        if (hipOccupancyMaxActiveBlocksPerMultiprocessor(&per_cu, (const void*)fwd_megakernel, NTHR, LDS_BYTES) != hipSuccess || per_cu < 1) per_cu = 1;
        (void)hipGetLastError();
        grid = cus * per_cu;
        if (grid < 1) grid = 256;
    }
    if (grid < 0) return;
    if (hipMemsetAsync((char*)d_ws + WS_BAR, 0, 16384, stream) != hipSuccess) { fprintf(stderr, "kernel_launch: memset failed\n"); return; }
    Args a{};
    for (int i = 0; i < 18; ++i) a.in[i] = (const float*)d_in[i];
    a.out = (float*)d_out; a.ws = (unsigned char*)d_ws;
#if MK_N_LAUNCHES == 1
    a.ph_lo = 0; a.ph_hi = NPHASE;
    void* args[] = {&a};
    hipError_t e = hipLaunchCooperativeKernel((const void*)fwd_megakernel, dim3(grid), dim3(NTHR), args, LDS_BYTES, stream);
    if (e != hipSuccess) fprintf(stderr, "cooperative launch failed: %s (grid %d)\n", hipGetErrorString(e), grid);
#else
    for (int ph = 0; ph < NPHASE; ++ph) { a.ph_lo = ph; a.ph_hi = ph + 1; hipLaunchKernelGGL(fwd_megakernel, dim3(grid), dim3(NTHR), LDS_BYTES, stream, a); }
#endif
}
```
